# Optimizing an MI355X kernel written in HIP

```python
import math
import jax
import jax.numpy as jnp
from jax import lax
import numpy as np

D_MODEL = 1024
BATCH = 8
SEQ = 2048
DEPTH = 4

D_HEAD = 64
N_MIXERS = 4
MIX_WIDTH = 256
NSA_HEADS = 4
NSA_ROT = D_HEAD // 4
CMP_BLOCK = 32
CMP_STRIDE = 16
SEL_BLOCK = 64
SEL_TOPN = 16
WINDOW = 512
FOX_HEADS = 4
MLA_HEADS = 4
MLA_Q_RANK = 256
MLA_KV_RANK = 128
MLA_NOPE = 64
MLA_ROPE = 32
MLA_V = 64
DIFF_HEADS = 4
DIFF_QK = 32
DIFF_V = 64
DIFF_ROT = DIFF_QK // 4
D_FF = 2816
CONV_WIDTH = 3
Q_BLOCK = 128
ROPE_THETA = 500000.0
EPS = 1e-6
FORCE_SCORE = 1e4
NEG_BIG = -1e30

IN_SPLITS = (
    NSA_HEADS * D_HEAD, D_HEAD, D_HEAD, D_HEAD, D_HEAD, D_HEAD, D_HEAD, 3 * NSA_HEADS,
    FOX_HEADS * D_HEAD, FOX_HEADS * D_HEAD, FOX_HEADS * D_HEAD, FOX_HEADS,
    MLA_Q_RANK, MLA_KV_RANK, MLA_ROPE,
    DIFF_HEADS * 2 * DIFF_QK, DIFF_HEADS * 2 * DIFF_QK, DIFF_HEADS * DIFF_V,
)
IN_WIDTH = sum(IN_SPLITS)

kernel_name = 'hybrid_nsa_fox_mla_diff_trunk'


def rms_norm(x, g=None, eps=EPS):
    xf = x.astype(jnp.float32)
    y = xf * lax.rsqrt(jnp.mean(xf * xf, axis=-1, keepdims=True) + eps)
    if g is not None:
        y = y * g.astype(jnp.float32)
    return y.astype(x.dtype)


def rope(x, pos, n_rot):
    half = n_rot // 2
    inv_freq = ROPE_THETA ** (-jnp.arange(half, dtype=jnp.float32) / half)
    ang = pos.astype(jnp.float32)[:, None, :, None] * inv_freq
    cos = jnp.cos(ang).astype(x.dtype)
    sin = jnp.sin(ang).astype(x.dtype)
    x1 = x[..., :half]
    x2 = x[..., half:n_rot]
    return jnp.concatenate([x1 * cos - x2 * sin, x2 * cos + x1 * sin, x[..., n_rot:]], axis=-1)


def heads(t, n):
    b, s, _ = t.shape
    return t.reshape(b, s, n, -1).transpose(0, 2, 1, 3)


def merge_heads(t):
    b, h, s, d = t.shape
    return t.transpose(0, 2, 1, 3).reshape(b, s, h * d)


def split_cols(t, sizes):
    idx = []
    acc = 0
    for s in sizes[:-1]:
        acc += s
        idx.append(acc)
    return jnp.split(t, idx, axis=-1)


def chunk_seq(t, axis):
    s = t.shape
    t = t.reshape(s[:axis] + (s[axis] // Q_BLOCK, Q_BLOCK) + s[axis + 1:])
    return jnp.moveaxis(t, axis, 0)


def unchunk_seq(t, axis):
    t = jnp.moveaxis(t, 0, axis)
    s = t.shape
    return t.reshape(s[:axis] + (s[axis] * s[axis + 1],) + s[axis + 2:])


def causal_attention(q, k, v, q_cum=None, k_cum=None):
    S = q.shape[2]
    scale = q.shape[-1] ** -0.5
    kpos = jnp.arange(S)

    def body(args):
        i, qb = args[0], args[1]
        s = jnp.einsum('bhqd,bhkd->bhqk', qb, k).astype(jnp.float32) * scale
        if q_cum is not None:
            s = s + args[2][..., None] - k_cum[:, :, None, :]
        qpos = i * Q_BLOCK + jnp.arange(Q_BLOCK)
        s = jnp.where(kpos[None, :] <= qpos[:, None], s, -jnp.inf)
        p = jax.nn.softmax(s, axis=-1).astype(v.dtype)
        return jnp.einsum('bhqk,bhkd->bhqd', p, v)

    xs = (jnp.arange(S // Q_BLOCK), chunk_seq(q, 2))
    if q_cum is not None:
        xs = xs + (chunk_seq(q_cum, 2),)
    return unchunk_seq(lax.map(body, xs), 2)


def compress_blocks(k, pe, w1, w2):
    b, s, d = k.shape
    halves = k.reshape(b, s // CMP_STRIDE, CMP_STRIDE, d)
    blocks = jnp.concatenate([halves[:, :-1], halves[:, 1:]], axis=2) + pe
    hid = jax.nn.silu(blocks.reshape(b, blocks.shape[1], CMP_BLOCK * d) @ w1)
    return hid @ w2


def selected_block_attention(q, k_blk, v_blk, sel_idx):
    b, h, S, d = q.shape
    scale = d ** -0.5
    gather = jax.vmap(lambda blocks, ix: blocks[ix])

    def body(args):
        i, qb, ib = args
        ksel = gather(k_blk, ib)
        vsel = gather(v_blk, ib)
        s = jnp.einsum('bhqd,bqnkd->bhqnk', qb, ksel).astype(jnp.float32) * scale
        qpos = i * Q_BLOCK + jnp.arange(Q_BLOCK)
        kpos = ib[..., None] * SEL_BLOCK + jnp.arange(SEL_BLOCK)
        mask = (kpos <= qpos[None, :, None, None])[:, None]
        s = jnp.where(mask, s, -jnp.inf)
        shp = s.shape
        p = jax.nn.softmax(s.reshape(shp[0], shp[1], shp[2], -1), axis=-1).reshape(shp).astype(vsel.dtype)
        return jnp.einsum('bhqnk,bqnkd->bhqd', p, vsel)

    out = lax.map(body, (jnp.arange(S // Q_BLOCK), chunk_seq(q, 2), chunk_seq(sel_idx, 1)))
    return unchunk_seq(out, 2)


def window_attention(q, k, v):
    b, h, S, d = q.shape
    scale = d ** -0.5
    kp = jnp.pad(k, ((0, 0), (WINDOW, 0), (0, 0)))
    vp = jnp.pad(v, ((0, 0), (WINDOW, 0), (0, 0)))
    span = Q_BLOCK + WINDOW

    def body(args):
        i, qb = args
        start = i * Q_BLOCK
        kb = lax.dynamic_slice_in_dim(kp, start, span, axis=1)
        vb = lax.dynamic_slice_in_dim(vp, start, span, axis=1)
        s = jnp.einsum('bhqd,bkd->bhqk', qb, kb).astype(jnp.float32) * scale
        qpos = start + jnp.arange(Q_BLOCK)
        kpos = start - WINDOW + jnp.arange(span)
        dist = qpos[:, None] - kpos[None, :]
        mask = (dist >= 0) & (dist < WINDOW) & (kpos[None, :] >= 0)
        p = jax.nn.softmax(jnp.where(mask, s, -jnp.inf), axis=-1).astype(vb.dtype)
        return jnp.einsum('bhqk,bkd->bhqd', p, vb)

    out = lax.map(body, (jnp.arange(S // Q_BLOCK), chunk_seq(q, 2)))
    return unchunk_seq(out, 2)


def nsa_mixer(parts, pos, qk_g, cmp_pe, cmp_w1, cmp_w2):
    q, k_c, v_c, k_s, v_s, k_w, v_w, g = parts
    b, S, _ = q.shape
    t = jnp.arange(S)
    q = rope(rms_norm(heads(q, NSA_HEADS), qk_g[0]), pos, NSA_ROT)
    k_cmp = rms_norm(compress_blocks(k_c, cmp_pe[0], cmp_w1[0], cmp_w2[0]), qk_g[1])
    v_cmp = compress_blocks(v_c, cmp_pe[1], cmp_w1[1], cmp_w2[1])
    n_cmp = k_cmp.shape[1]
    cmp_end = jnp.arange(n_cmp) * CMP_STRIDE + (CMP_BLOCK - 1)
    vis = cmp_end[None, :] <= t[:, None]
    s = jnp.einsum('bhsd,bcd->bhsc', q, k_cmp).astype(jnp.float32) * (D_HEAD ** -0.5)
    p_cmp = jax.nn.softmax(jnp.where(vis, s, NEG_BIG), axis=-1)
    p_cmp = jnp.where(jnp.any(vis, axis=-1)[:, None], p_cmp, 0.0)
    o_cmp = jnp.einsum('bhsc,bcd->bhsd', p_cmp.astype(v_cmp.dtype), v_cmp)
    n_blk = S // SEL_BLOCK
    n_sel = min(SEL_TOPN, n_blk)
    cs = np.arange(n_cmp)[:, None] * CMP_STRIDE
    bs = np.arange(n_blk)[None, :] * SEL_BLOCK
    overlap = jnp.asarray(((cs < bs + SEL_BLOCK) & (cs + CMP_BLOCK > bs)).astype(np.float32))
    importance = jnp.einsum('bhsc,cj->bsj', p_cmp, overlap)
    blk = jnp.arange(n_blk)[None, :]
    cur = (t // SEL_BLOCK)[:, None]
    forced = (blk == 0) | (blk == cur) | (blk == cur - 1)
    score = jnp.where(blk * SEL_BLOCK > t[:, None], -1.0, jnp.where(forced, FORCE_SCORE, importance))
    _, sel_idx = lax.top_k(score, n_sel)
    k_s = rope(rms_norm(k_s[:, None], qk_g[2]), pos, NSA_ROT)[:, 0]
    o_slc = selected_block_attention(q, k_s.reshape(b, n_blk, SEL_BLOCK, D_HEAD),
                                     v_s.reshape(b, n_blk, SEL_BLOCK, D_HEAD), sel_idx)
    k_w = rope(rms_norm(k_w[:, None], qk_g[3]), pos, NSA_ROT)[:, 0]
    o_win = window_attention(q, k_w, v_w)
    gt = jax.nn.sigmoid(g.astype(jnp.float32)).astype(q.dtype)
    gt = gt.reshape(b, S, 3, NSA_HEADS).transpose(2, 0, 3, 1)[..., None]
    return merge_heads(gt[0] * o_cmp + gt[1] * o_slc + gt[2] * o_win)


def fox_mixer(parts, qk_g, f_b):
    q, k, v, f = parts
    q = rms_norm(heads(q, FOX_HEADS), qk_g[0])
    k = rms_norm(heads(k, FOX_HEADS), qk_g[1])
    v = heads(v, FOX_HEADS)
    log_f = jax.nn.log_sigmoid(f.astype(jnp.float32) + f_b.astype(jnp.float32))
    cum = lax.cumsum(log_f, axis=1).transpose(0, 2, 1)
    return merge_heads(causal_attention(q, k, v, cum, cum))


def mla_mixer(parts, pos, cq_g, ckv_g, w_uq, w_ukv, qk_g):
    c_q, c_kv, k_rope = parts
    b, S, _ = c_q.shape
    q = heads(rms_norm(c_q, cq_g) @ w_uq, MLA_HEADS)
    kv = heads(rms_norm(c_kv, ckv_g) @ w_ukv, MLA_HEADS)
    k_nope, v = kv[..., :MLA_NOPE], kv[..., MLA_NOPE:]
    k = jnp.concatenate([jnp.broadcast_to(k_rope[:, None], (b, MLA_HEADS, S, MLA_ROPE)), k_nope], axis=-1)
    q = rope(rms_norm(q, qk_g[0]), pos, MLA_ROPE)
    k = rope(rms_norm(k, qk_g[1]), pos, MLA_ROPE)
    return merge_heads(causal_attention(q, k, v))


def diff_mixer(parts, pos, lam_init, qk_g, lam_vec, out_g):
    q, k, v = parts
    b, S, _ = q.shape

    def halves(t):
        return t.reshape(b, S, DIFF_HEADS, 2, DIFF_QK).transpose(3, 0, 2, 1, 4)

    q = rope(rms_norm(halves(q), qk_g[0]), pos, DIFF_ROT)
    k = rope(rms_norm(halves(k), qk_g[1]), pos, DIFF_ROT)
    v = heads(v, DIFF_HEADS)
    lv = lam_vec.astype(jnp.float32)
    lam = jnp.exp(jnp.sum(lv[0] * lv[1])) - jnp.exp(jnp.sum(lv[2] * lv[3])) + lam_init
    o = causal_attention(q[0], k[0], v) - lam.astype(v.dtype) * causal_attention(q[1], k[1], v)
    return merge_heads(rms_norm(o, out_g) * (1.0 - lam_init))


def token_mixer(h, pos, lam_init, w_in, nsa_qk_g, nsa_cmp_pe, nsa_cmp_w1, nsa_cmp_w2, fox_qk_g, fox_f_b,
                mla_cq_g, mla_ckv_g, mla_w_uq, mla_w_ukv, mla_qk_g, diff_qk_g, diff_lambda, diff_out_g,
                br_w, gate_w, gate_b, w_out):
    b, S, D = h.shape
    parts = split_cols(h @ w_in, IN_SPLITS)
    o_nsa = nsa_mixer(parts[0:8], pos, nsa_qk_g, nsa_cmp_pe, nsa_cmp_w1, nsa_cmp_w2)
    o_fox = fox_mixer(parts[8:12], fox_qk_g, fox_f_b)
    o_mla = mla_mixer(parts[12:15], pos, mla_cq_g, mla_ckv_g, mla_w_uq, mla_w_ukv, mla_qk_g)
    o_diff = diff_mixer(parts[15:18], pos, lam_init, diff_qk_g, diff_lambda, diff_out_g)
    branches = jnp.stack([o_nsa, o_fox, o_mla, o_diff], axis=2)
    y = jnp.einsum('bsmc,mcd->bsmd', branches, br_w)
    gates = jax.nn.sigmoid((h @ gate_w + gate_b).astype(jnp.float32)).astype(h.dtype)
    gates = gates.reshape(b, S, N_MIXERS, D)
    return jnp.sum(gates * y, axis=2) @ w_out


def conv_ffn(h, w_up, conv_w, conv_b, w_down):
    g, v = jnp.split(h @ w_up, 2, axis=-1)
    g = lax.conv_general_dilated(g, conv_w[:, None, :].astype(g.dtype), window_strides=(1,),
                                 padding=[(CONV_WIDTH - 1, 0)], dimension_numbers=('NWC', 'WIO', 'NWC'),
                                 feature_group_count=g.shape[-1]) + conv_b
    return (jax.nn.silu(g) * v) @ w_down


def setup_inputs(seed: int = 0) -> dict:
    key = jax.random.key(seed)
    ks = iter(jax.random.split(key, 40))

    def nrm(shape, scale):
        return jax.random.normal(next(ks), shape, jnp.float32) * scale

    def gain(shape):
        return 1.0 + nrm(shape, 0.02)

    L, D = DEPTH, D_MODEL
    x = nrm((BATCH, SEQ, D), 1.0)
    c = nrm((BATCH, D), 1.0)
    positions = (jax.random.randint(next(ks), (BATCH, 1), 0, 4096, dtype=jnp.int32)
                 + jnp.arange(SEQ, dtype=jnp.int32)[None, :])
    return {
        'x': x,
        'c': c,
        'positions': positions,
        'ada_w': nrm((L, D, 6 * D), 0.5 * D ** -0.5),
        'ada_b': nrm((L, 6 * D), 0.02),
        'w_in': nrm((L, D, IN_WIDTH), D ** -0.5),
        'nsa_qk_g': gain((L, 4, D_HEAD)),
        'nsa_cmp_pe': nrm((L, 2, CMP_BLOCK, D_HEAD), 0.1),
        'nsa_cmp_w1': nrm((L, 2, CMP_BLOCK * D_HEAD, D_HEAD), (CMP_BLOCK * D_HEAD) ** -0.5),
        'nsa_cmp_w2': nrm((L, 2, D_HEAD, D_HEAD), D_HEAD ** -0.5),
        'fox_qk_g': gain((L, 2, D_HEAD)),
        'fox_f_b': 3.0 + nrm((L, FOX_HEADS), 0.5),
        'mla_cq_g': gain((L, MLA_Q_RANK)),
        'mla_ckv_g': gain((L, MLA_KV_RANK)),
        'mla_w_uq': nrm((L, MLA_Q_RANK, MLA_HEADS * (MLA_ROPE + MLA_NOPE)), MLA_Q_RANK ** -0.5),
        'mla_w_ukv': nrm((L, MLA_KV_RANK, MLA_HEADS * (MLA_NOPE + MLA_V)), MLA_KV_RANK ** -0.5),
        'mla_qk_g': gain((L, 2, MLA_ROPE + MLA_NOPE)),
        'diff_qk_g': gain((L, 2, DIFF_QK)),
        'diff_lambda': nrm((L, 4, DIFF_QK), 0.1),
        'diff_out_g': gain((L, DIFF_V)),
        'br_w': nrm((L, N_MIXERS, MIX_WIDTH, D), MIX_WIDTH ** -0.5),
        'gate_w': nrm((L, D, N_MIXERS * D), D ** -0.5),
        'gate_b': nrm((L, N_MIXERS * D), 0.02),
        'w_out': nrm((L, D, D), D ** -0.5),
        'ffn_w_up': nrm((L, D, 2 * D_FF), D ** -0.5),
        'ffn_conv_w': nrm((L, CONV_WIDTH, D_FF), CONV_WIDTH ** -0.5),
        'ffn_conv_b': nrm((L, D_FF), 0.02),
        'ffn_w_down': nrm((L, D_FF, D), D_FF ** -0.5),
    }


def reference(x, c, positions, ada_w, ada_b, w_in, nsa_qk_g, nsa_cmp_pe, nsa_cmp_w1, nsa_cmp_w2,
              fox_qk_g, fox_f_b, mla_cq_g, mla_ckv_g, mla_w_uq, mla_w_ukv, mla_qk_g,
              diff_qk_g, diff_lambda, diff_out_g, br_w, gate_w, gate_b, w_out,
              ffn_w_up, ffn_conv_w, ffn_conv_b, ffn_w_down):
    for l in range(DEPTH):
        mod = jax.nn.silu(c) @ ada_w[l] + ada_b[l]
        sh1, sc1, g1, sh2, sc2, g2 = jnp.split(mod[:, None, :], 6, axis=-1)
        lam_init = 0.8 - 0.6 * math.exp(-0.3 * l)
        h = rms_norm(x) * (1.0 + sc1) + sh1
        x = x + g1 * token_mixer(h, positions, lam_init, w_in[l], nsa_qk_g[l], nsa_cmp_pe[l], nsa_cmp_w1[l],
                                 nsa_cmp_w2[l], fox_qk_g[l], fox_f_b[l], mla_cq_g[l], mla_ckv_g[l],
                                 mla_w_uq[l], mla_w_ukv[l], mla_qk_g[l], diff_qk_g[l], diff_lambda[l],
                                 diff_out_g[l], br_w[l], gate_w[l], gate_b[l], w_out[l])
        h = rms_norm(x) * (1.0 + sc2) + sh2
        x = x + g2 * conv_ffn(h, ffn_w_up[l], ffn_conv_w[l], ffn_conv_b[l], ffn_w_down[l])
    return x
```

```cpp
#include <hip/hip_runtime.h>
#include <hip/hip_cooperative_groups.h>
#include <stdint.h>
#include <stdio.h>
#include <math.h>
namespace cg = cooperative_groups;

typedef unsigned short bf16_t;
typedef short bf16x8 __attribute__((ext_vector_type(8)));
typedef short s16x4 __attribute__((ext_vector_type(4)));
typedef float f32x16 __attribute__((ext_vector_type(16)));
typedef float f32x4 __attribute__((ext_vector_type(4)));
typedef float f32x2 __attribute__((ext_vector_type(2)));
typedef unsigned u32x4 __attribute__((ext_vector_type(4)));
typedef unsigned u32x2 __attribute__((ext_vector_type(2)));
typedef __bf16 bfv2 __attribute__((ext_vector_type(2)));

#define DI __device__ __forceinline__
#define MFMA32(a, b, c) __builtin_amdgcn_mfma_f32_32x32x16_bf16((a), (b), (c), 0, 0, 0)

constexpr int NB = 8, S = 2048, D = 1024, M = NB * S, NL = 4;
constexpr int NIN = 2608, NINP = 2688, DFF = 2816;
constexpr float EPS = 1e-6f;
constexpr int NT = 256;

constexpr size_t al256(size_t x) { return (x + 255) & ~(size_t)255; }
constexpr size_t WS_CTR = 0;
constexpr size_t WS_MOD = 256;
constexpr size_t WS_ROPE = al256(WS_MOD + (size_t)NL * NB * 6144 * 4);
constexpr size_t WS_W = al256(WS_ROPE + (size_t)M * 28 * 8);
constexpr size_t W_IN = 0;
constexpr size_t W_G = W_IN + (size_t)NINP * 1024 * 2;
constexpr size_t W_BR = W_G + (size_t)4096 * 1024 * 2;
constexpr size_t W_O = W_BR + (size_t)1024 * 1024 * 2;
constexpr size_t W_UP = W_O + (size_t)1024 * 1024 * 2;
constexpr size_t W_DN = W_UP + (size_t)5632 * 1024 * 2;
constexpr size_t W_UQ = W_DN + (size_t)1024 * 2816 * 2;
constexpr size_t W_UKV = W_UQ + (size_t)384 * 256 * 2;
constexpr size_t W_END = W_UKV + (size_t)512 * 128 * 2;
constexpr size_t WS_H = al256(WS_W + W_END);
constexpr size_t WS_R1 = al256(WS_H + (size_t)M * 1024 * 2);
constexpr size_t R1_GATES = 0;
constexpr int GLD = 4160;
constexpr size_t R1_OBUF = (size_t)M * GLD * 2;
constexpr size_t R1_ABUF = 0;
constexpr size_t WS_R2 = al256(WS_R1 + (size_t)M * NINP * 4);
constexpr size_t R2_QNSA = 0;
constexpr size_t R2_QFNSA = R2_QNSA + (size_t)M * 256 * 2;
constexpr size_t R2_KS = R2_QFNSA + (size_t)M * 256 * 4;
constexpr size_t R2_KW = R2_KS + (size_t)M * 64 * 2;
constexpr size_t R2_VTS = R2_KW + (size_t)M * 64 * 2;
constexpr size_t R2_VTW = R2_VTS + (size_t)M * 64 * 2;
constexpr size_t R2_GN = R2_VTW + (size_t)M * 64 * 2;
constexpr size_t R2_KCMP = R2_GN + (size_t)M * 12 * 4;
constexpr size_t R2_VCMP = R2_KCMP + (size_t)NB * 128 * 64 * 4;
constexpr size_t R2_OCMP = R2_VCMP + (size_t)NB * 128 * 64 * 4;
constexpr size_t R2_SELM = R2_OCMP + (size_t)M * 256 * 4;
constexpr size_t R2_FQ = R2_SELM + (size_t)M * 4;
constexpr size_t R2_FK = R2_FQ + (size_t)M * 256 * 2;
constexpr size_t R2_FVT = R2_FK + (size_t)M * 256 * 2;
constexpr size_t R2_CUM = R2_FVT + (size_t)M * 256 * 2;
constexpr size_t R2_MQ = R2_CUM + (size_t)NB * 4 * S * 4;
constexpr size_t R2_MK = R2_MQ + (size_t)M * 384 * 2;
constexpr size_t R2_MVT = R2_MK + (size_t)M * 384 * 2;
constexpr size_t R2_DQ = R2_MVT + (size_t)M * 256 * 2;
constexpr size_t R2_DK = R2_DQ + (size_t)M * 256 * 2;
constexpr size_t R2_DVT = R2_DK + (size_t)M * 256 * 2;
constexpr size_t R2_DTMP = R2_DVT + (size_t)M * 256 * 2;
constexpr size_t R2_NTMP = R2_DTMP + (size_t)M * 256 * 4;
constexpr size_t R2_END = R2_NTMP + (size_t)M * 256 * 4;
constexpr size_t WS_BAR = al256(WS_R2 + R2_END);
constexpr size_t WS_END = WS_BAR + 16384;

constexpr int LDS_BYTES = 73728;
#ifndef PROBE_SUB
#define PROBE_SUB (-1)
#endif
#ifndef PROBE_MASK
#define PROBE_MASK 0u
#endif
#ifndef EN_MASK
#define EN_MASK 0xffffu
#endif
#define EN(k) ((EN_MASK >> (k)) & 1u)
#ifndef TY_MASK
#define TY_MASK 0xfu
#endif
#define TY(k) ((TY_MASK >> (k)) & 1u)

struct Params {
    const float* in[28];
    float* out;
    unsigned char* ws;
    int ph_lo, ph_hi;
};

DI unsigned pk2(float a, float b) { f32x2 v = {a, b}; bfv2 r = __builtin_convertvector(v, bfv2); return __builtin_bit_cast(unsigned, r); }
DI bf16_t f2bf(float a) { return (bf16_t)(pk2(a, 0.f) & 0xffffu); }
DI float bf2f(bf16_t v) { return __uint_as_float(((unsigned)v) << 16); }
template <int CTRL> DI float dpp_f(float v) { return __builtin_bit_cast(float, __builtin_amdgcn_update_dpp(0, __builtin_bit_cast(int, v), CTRL, 0xf, 0xf, true)); }
DI float sum16_dpp(float v) {
    v += dpp_f<0xB1>(v);
    v += dpp_f<0x4E>(v);
    v += dpp_f<0x141>(v);
    v += dpp_f<0x140>(v);
    return v;
}
DI float wsum(float v) {
    v = sum16_dpp(v);
    v += __shfl_xor(v, 16);
    v += __shfl_xor(v, 32);
    return v;
}
DI float wmax(float v) {
#pragma unroll
    for (int o = 1; o < 64; o <<= 1) v = fmaxf(v, __shfl_xor(v, o));
    return v;
}
DI float sum32(float v) {
    v = sum16_dpp(v);
    v += __shfl_xor(v, 16);
    return v;
}
DI float sigmoidf_(float x) { return __builtin_amdgcn_rcpf(1.f + __builtin_amdgcn_exp2f(-1.4426950408889634f * x)); }
DI float siluf_(float x) { return x * __builtin_amdgcn_rcpf(1.f + __builtin_amdgcn_exp2f(-1.4426950408889634f * x)); }
DI int crow(int i, int hh) { return (i & 3) + 8 * (i >> 2) + 4 * hh; }

DI void tc_tile(const float* __restrict__ src, int ld, int nvalid, int k0, int n0, bf16_t* __restrict__ dst, int ldd, int drow0, float* sm, int tid) {
#pragma unroll
    for (int p = 0; p < 4; ++p) {
        const int r = p * 16 + (tid >> 4), c4 = (tid & 15) * 4;
        f32x4 v = {0.f, 0.f, 0.f, 0.f};
        if (n0 + c4 < nvalid) v = *(const f32x4*)(src + (size_t)(k0 + r) * ld + n0 + c4);
        sm[r * 65 + c4 + 0] = v[0]; sm[r * 65 + c4 + 1] = v[1]; sm[r * 65 + c4 + 2] = v[2]; sm[r * 65 + c4 + 3] = v[3];
    }
    __syncthreads();
    const int n = tid >> 2, ks = (tid & 3) * 16;
    unsigned w[8];
#pragma unroll
    for (int i = 0; i < 8; ++i) w[i] = pk2(sm[(ks + 2 * i) * 65 + n], sm[(ks + 2 * i + 1) * 65 + n]);
    u32x4* d = (u32x4*)(dst + (size_t)(drow0 + n) * ldd + k0 + ks);
    d[0] = (u32x4){w[0], w[1], w[2], w[3]};
    d[1] = (u32x4){w[4], w[5], w[6], w[7]};
    __syncthreads();
}

DI void tc_matrix(const float* src, int K, int N, bf16_t* dst, int ldd, float* sm, int mode  , int tid) {
    const int nkt = K / 64, nnt = (N + 63) / 64;
    for (int j = blockIdx.x; j < nkt * nnt; j += gridDim.x) {
        const int tn = j / nkt, tk = j % nkt;
        int drow0 = tn * 64;
        if (mode == 1) drow0 = (tn < 44) ? tn * 128 : (tn - 44) * 128 + 64;
        tc_tile(src, N, N, tk * 64, tn * 64, dst, ldd, drow0, sm, tid);
    }
}

struct NoHook { template <class T> DI void operator()(int, T&) const {} };

template <int NTW, class AR, class HK>
DI void gemm_main(const bf16_t* __restrict__ A, int lda, AR arow, const bf16_t* __restrict__ Bt, int ldb, int col0, int nk,
                  f32x16 (&acc)[2][NTW], unsigned char* smraw, HK hook, int tid) {
    constexpr int BROWS = 64 * NTW, NBL = 2 * NTW;
    bf16_t* sa = (bf16_t*)smraw;
    bf16_t* sb = sa + 2 * 128 * 72;
    const int lane = tid & 63, wave = __builtin_amdgcn_readfirstlane(tid >> 6), wr = wave >> 1, wc = wave & 1, r32 = lane & 31, hh = lane >> 5;
    const int lr = tid >> 3, lc = (tid & 7) * 8;
    const bf16_t* ap[4];
    const bf16_t* bp[NBL];
#pragma unroll
    for (int p = 0; p < 4; ++p) ap[p] = A + (size_t)arow(p * 32 + lr) * lda + lc;
#pragma unroll
    for (int p = 0; p < NBL; ++p) bp[p] = Bt + (size_t)(col0 + p * 32 + lr) * ldb + lc;
    u32x4 ra0[4], rb0[NBL], ra1[4], rb1[NBL];
#define G_LOAD(RA, RB, KT) { _Pragma("unroll") for (int p = 0; p < 4; ++p) RA[p] = *(const u32x4*)(ap[p] + (KT) * 64); _Pragma("unroll") for (int p = 0; p < NBL; ++p) RB[p] = *(const u32x4*)(bp[p] + (KT) * 64); }
#define G_STORE(RA, RB, BUF) { bf16_t* wa = sa + (BUF) * 128 * 72; bf16_t* wb = sb + (BUF) * BROWS * 72; _Pragma("unroll") for (int p = 0; p < 4; ++p) *(u32x4*)(wa + (p * 32 + lr) * 72 + lc) = RA[p]; _Pragma("unroll") for (int p = 0; p < NBL; ++p) *(u32x4*)(wb + (p * 32 + lr) * 72 + lc) = RB[p]; }
#define G_COMPUTE(BUF) { __builtin_amdgcn_s_setprio(1); const bf16_t* ca = sa + (BUF) * 128 * 72 + (wr * 64 + r32) * 72 + hh * 8; const bf16_t* cb = sb + (BUF) * BROWS * 72 + (wc * 32 * NTW + r32) * 72 + hh * 8; \
        _Pragma("unroll") for (int ks = 0; ks < 4; ++ks) { const bf16x8 a0 = *(const bf16x8*)(ca + ks * 16), a1 = *(const bf16x8*)(ca + 32 * 72 + ks * 16); \
            _Pragma("unroll") for (int nt = 0; nt < NTW; ++nt) { const bf16x8 b0 = *(const bf16x8*)(cb + nt * 32 * 72 + ks * 16); acc[0][nt] = MFMA32(a0, b0, acc[0][nt]); acc[1][nt] = MFMA32(a1, b0, acc[1][nt]); } }  __builtin_amdgcn_s_setprio(0); }
    G_LOAD(ra0, rb0, 0);
    G_LOAD(ra1, rb1, 1);
    G_STORE(ra0, rb0, 0);
    __syncthreads();
    for (int kt = 0; kt < nk; kt += 2) {
        if (kt + 2 < nk) G_LOAD(ra0, rb0, kt + 2);
        __builtin_amdgcn_sched_barrier(0);
        G_COMPUTE(0);
        hook(kt, acc);
        G_STORE(ra1, rb1, 1);
        __syncthreads();
        if (kt + 3 < nk) G_LOAD(ra1, rb1, kt + 3);
        __builtin_amdgcn_sched_barrier(0);
        G_COMPUTE(1);
        hook(kt + 1, acc);
        if (kt + 2 < nk) G_STORE(ra0, rb0, 0);
        __syncthreads();
    }
#undef G_LOAD
#undef G_STORE
#undef G_COMPUTE
}

template <int NTW, class AR, class HK>
DI void gemm_main1(const bf16_t* __restrict__ A, int lda, AR arow, const bf16_t* __restrict__ Bt, int ldb, int col0, int nk,
                  f32x16 (&acc)[2][NTW], unsigned char* smraw, HK hook, int tid) {
    constexpr int BROWS = 64 * NTW, NBL = 2 * NTW;
    bf16_t* sa = (bf16_t*)smraw;
    bf16_t* sb = sa + 2 * 128 * 72;
    const int lane = tid & 63, wave = __builtin_amdgcn_readfirstlane(tid >> 6), wr = wave >> 1, wc = wave & 1, r32 = lane & 31, hh = lane >> 5;
    const int lr = tid >> 3, lc = (tid & 7) * 8;
    const bf16_t* ap[4];
    const bf16_t* bp[NBL];
#pragma unroll
    for (int p = 0; p < 4; ++p) ap[p] = A + (size_t)arow(p * 32 + lr) * lda + lc;
#pragma unroll
    for (int p = 0; p < NBL; ++p) bp[p] = Bt + (size_t)(col0 + p * 32 + lr) * ldb + lc;
    u32x4 ra[4], rb[NBL];
#pragma unroll
    for (int p = 0; p < 4; ++p) ra[p] = *(const u32x4*)(ap[p]);
#pragma unroll
    for (int p = 0; p < NBL; ++p) rb[p] = *(const u32x4*)(bp[p]);
#pragma unroll
    for (int p = 0; p < 4; ++p) *(u32x4*)(sa + (p * 32 + lr) * 72 + lc) = ra[p];
#pragma unroll
    for (int p = 0; p < NBL; ++p) *(u32x4*)(sb + (p * 32 + lr) * 72 + lc) = rb[p];
    __syncthreads();
    for (int kt = 0; kt < nk; ++kt) {
        const int buf = kt & 1;
        if (kt + 1 < nk) {
#pragma unroll
            for (int p = 0; p < 4; ++p) ra[p] = *(const u32x4*)(ap[p] + (kt + 1) * 64);
#pragma unroll
            for (int p = 0; p < NBL; ++p) rb[p] = *(const u32x4*)(bp[p] + (kt + 1) * 64);
        }
        __builtin_amdgcn_sched_barrier(0);
        const bf16_t* ca = sa + buf * 128 * 72 + (wr * 64 + r32) * 72 + hh * 8;
        const bf16_t* cb = sb + buf * BROWS * 72 + (wc * 32 * NTW + r32) * 72 + hh * 8;
#pragma unroll
        for (int ks = 0; ks < 4; ++ks) {
            const bf16x8 a0 = *(const bf16x8*)(ca + ks * 16), a1 = *(const bf16x8*)(ca + 32 * 72 + ks * 16);
#pragma unroll
            for (int nt = 0; nt < NTW; ++nt) {
                const bf16x8 b0 = *(const bf16x8*)(cb + nt * 32 * 72 + ks * 16);
                acc[0][nt] = MFMA32(a0, b0, acc[0][nt]);
                acc[1][nt] = MFMA32(a1, b0, acc[1][nt]);
            }
        }
        hook(kt, acc);
        if (kt + 1 < nk) {
            bf16_t* wa = sa + (buf ^ 1) * 128 * 72;
            bf16_t* wb = sb + (buf ^ 1) * BROWS * 72;
#pragma unroll
            for (int p = 0; p < 4; ++p) *(u32x4*)(wa + (p * 32 + lr) * 72 + lc) = ra[p];
#pragma unroll
            for (int p = 0; p < NBL; ++p) *(u32x4*)(wb + (p * 32 + lr) * 72 + lc) = rb[p];
        }
        __syncthreads();
    }
}

struct RowPlain { int r0; DI int operator()(int r) const { return r0 + r; } };
struct RowClamp { int base, t0; DI int operator()(int r) const { int t = t0 + r; t = t < 0 ? 0 : (t > S - 1 ? S - 1 : t); return base + t; } };

DI void zero_acc(f32x16 (&acc)[2][2]) {
#pragma unroll
    for (int a = 0; a < 2; ++a)
#pragma unroll
        for (int b = 0; b < 2; ++b)
#pragma unroll
            for (int i = 0; i < 16; ++i) acc[a][b][i] = 0.f;
}

DI void attn_pass(const bf16_t* __restrict__ Qp, int qs, const bf16_t* __restrict__ Kp, int ksr, const bf16_t* __restrict__ Vt,
                  const float* __restrict__ cum, const unsigned* __restrict__ selm, float scale, int nks, int mode, int q0,
                  f32x16 (&O)[2], unsigned char* smraw, int wave, int lane, int tid) {
    constexpr int KROW = 104, KT = 64 * KROW, VT = 64 * 68;
    bf16_t* sK = (bf16_t*)smraw;
    bf16_t* sV = sK + 2 * KT;
    float* sC = (float*)(smraw + 2 * KT * 2 + 2 * VT * 2);
    const int r32 = lane & 31, hh = lane >> 5;
    const int qw = q0 + wave * 32, t = qw + r32;
    bf16x8* sQ = (bf16x8*)(smraw + 2 * KT * 2 + 2 * VT * 2 + 512) + wave * 6 * 64 + lane;
#pragma unroll
    for (int ks = 0; ks < 6; ++ks) if (ks < nks) sQ[ks * 64] = *(const bf16x8*)(Qp + (size_t)t * qs + ks * 16 + hh * 8);
    float cq = 0.f; unsigned smk = 0xffffffffu;
    if (mode == 1) cq = cum[t];
    if (mode == 2) smk = selm[t];
    const int win = (mode == 3) ? 512 : (1 << 30);
    const float c2 = scale * 1.4426950408889634f, ic2 = 1.f / scale;
    int kt0 = 0; const int kt1 = q0 / 64 + 2;
    if (mode == 3) { kt0 = q0 / 64 - 8; if (kt0 < 0) kt0 = 0; }
#pragma unroll
    for (int i = 0; i < 16; ++i) { O[0][i] = 0.f; O[1][i] = 0.f; }
    float m = -1e30f, l = 0.f;
    const int nkc = nks >> 1, cpr = nks * 2;
    int krc[3];
#pragma unroll
    for (int p = 0; p < 3; ++p) { const int c = p * 256 + tid, row = c / cpr, cc = c - row * cpr; krc[p] = row | (cc << 8); }
#define KG(p) ((krc[p] & 255) * ksr + (krc[p] >> 8) * 8)
#define KL(p) ((krc[p] & 255) * KROW + (krc[p] >> 8) * 8)
#define VG(p) ((((p) * 256 + tid) >> 3) * S + (((p) * 256 + tid) & 7) * 8)
#define VL(p) ((((p) * 256 + tid) >> 3) * 68 + (((p) * 256 + tid) & 7) * 8)
    u32x4 rk[3], rv[2]; float rc = 0.f;
    {
        const bf16_t* kp = Kp + (size_t)kt0 * 64 * ksr; const bf16_t* vp = Vt + kt0 * 64;
#pragma unroll
        for (int p = 0; p < 3; ++p) if (p < nkc) rk[p] = *(const u32x4*)(kp + KG(p));
#pragma unroll
        for (int p = 0; p < 2; ++p) rv[p] = *(const u32x4*)(vp + VG(p));
        if (mode == 1 && tid < 64) rc = cum[kt0 * 64 + tid];
#pragma unroll
        for (int p = 0; p < 3; ++p) if (p < nkc) *(u32x4*)(sK + KL(p)) = rk[p];
#pragma unroll
        for (int p = 0; p < 2; ++p) { u32x2* d = (u32x2*)(sV + VL(p)); d[0] = (u32x2){rv[p][0], rv[p][1]}; d[1] = (u32x2){rv[p][2], rv[p][3]}; }
        if (mode == 1 && tid < 64) sC[tid] = rc;
    }
    __syncthreads();
    for (int kt = kt0; kt < kt1; ++kt) {
        const int buf = (kt - kt0) & 1;
        if (kt + 1 < kt1) {
            const bf16_t* kp = Kp + (size_t)(kt + 1) * 64 * ksr; const bf16_t* vp = Vt + (kt + 1) * 64;
#pragma unroll
            for (int p = 0; p < 3; ++p) if (p < nkc) rk[p] = *(const u32x4*)(kp + KG(p));
#pragma unroll
            for (int p = 0; p < 2; ++p) rv[p] = *(const u32x4*)(vp + VG(p));
            if (mode == 1 && tid < 64) rc = cum[(kt + 1) * 64 + tid];
        }
        bool act = (kt * 64 <= qw + 31) && (kt * 64 + 63 > qw - win);
        const bool selb = ((smk >> kt) & 1u) != 0u;
        const unsigned long long selbal = __ballot(selb);
        act = act && (selbal != 0ull);
        if (act) {
            const bool full = (kt * 64 + 63 <= qw) && (kt * 64 > qw + 31 - win) && (selbal == ~0ull);
#pragma nounroll
            for (int kb = 0; kb < 2; ++kb) {
                f32x16 Sx;
#pragma unroll
                for (int i = 0; i < 16; ++i) Sx[i] = 0.f;
                const bf16_t* kr = sK + buf * KT + (kb * 32 + r32) * KROW + hh * 8;
#pragma unroll
                for (int ks = 0; ks < 6; ++ks) if (ks < nks) { const bf16x8 a = *(const bf16x8*)(kr + ks * 16); const bf16x8 qv = sQ[ks * 64]; Sx = MFMA32(a, qv, Sx); }
                if (mode == 1) {
#pragma unroll
                    for (int g = 0; g < 4; ++g) {
                        const f32x4 ck = *(const f32x4*)(sC + buf * 64 + kb * 32 + 8 * g + 4 * hh);
#pragma unroll
                        for (int e = 0; e < 4; ++e) Sx[4 * g + e] += (cq - ck[e]) * ic2;
                    }
                }
                if (!full) {
                    const int kbase = kt * 64 + kb * 32 + 4 * hh;
#pragma unroll
                    for (int i = 0; i < 16; ++i) {
                        const int key = kbase + (i & 3) + 8 * (i >> 2);
                        const bool ok = (key <= t) && (key > t - win) && selb;
                        Sx[i] = ok ? Sx[i] : -3e38f;
                    }
                }
                float mx = -3e38f;
#pragma unroll
                for (int i = 0; i < 16; ++i) mx = fmaxf(mx, Sx[i]);
                mx = fmaxf(mx, __shfl_xor(mx, 32));
                mx = fmaxf(mx * c2, -1e30f);
                const float mn = fmaxf(m, mx), alpha = __builtin_amdgcn_exp2f(m - mn);
                m = mn;
                const float mneg = -mn;
#pragma unroll
                for (int i = 0; i < 16; ++i) { O[0][i] *= alpha; O[1][i] *= alpha; }
                float rs = 0.f;
#pragma unroll
                for (int i = 0; i < 16; ++i) { const float pp = __builtin_amdgcn_exp2f(fmaf(Sx[i], c2, mneg)); Sx[i] = pp; rs += pp; }
                l = l * alpha + rs;
#pragma unroll
                for (int s2 = 0; s2 < 2; ++s2) {
                    u32x4 pw;
                    pw[0] = pk2(Sx[8 * s2 + 0], Sx[8 * s2 + 1]); pw[1] = pk2(Sx[8 * s2 + 2], Sx[8 * s2 + 3]);
                    pw[2] = pk2(Sx[8 * s2 + 4], Sx[8 * s2 + 5]); pw[3] = pk2(Sx[8 * s2 + 6], Sx[8 * s2 + 7]);
                    const bf16x8 pb = __builtin_bit_cast(bf16x8, pw);
#pragma unroll
                    for (int dvb = 0; dvb < 2; ++dvb) {
                        const bf16_t* vr = sV + buf * VT + (dvb * 32 + r32) * 68 + kb * 32 + 16 * s2 + 4 * hh;
                        const s16x4 lo = *(const s16x4*)vr, hi = *(const s16x4*)(vr + 8);
                        const bf16x8 va = __builtin_shufflevector(lo, hi, 0, 1, 2, 3, 4, 5, 6, 7);
                        O[dvb] = MFMA32(va, pb, O[dvb]);
                    }
                }
            }
        }
        if (kt + 1 < kt1) {
            const int nb = buf ^ 1;
#pragma unroll
            for (int p = 0; p < 3; ++p) if (p < nkc) *(u32x4*)(sK + nb * KT + KL(p)) = rk[p];
#pragma unroll
            for (int p = 0; p < 2; ++p) { u32x2* d = (u32x2*)(sV + nb * VT + VL(p)); d[0] = (u32x2){rv[p][0], rv[p][1]}; d[1] = (u32x2){rv[p][2], rv[p][3]}; }
            if (mode == 1 && tid < 64) sC[nb * 64 + tid] = rc;
        }
        __syncthreads();
    }
    l += __shfl_xor(l, 32);
    const float inv = 1.f / l;
#pragma unroll
    for (int i = 0; i < 16; ++i) { O[0][i] *= inv; O[1][i] *= inv; }
}

DI void store_o(bf16_t* dst, const f32x16 (&O)[2], int hh) {
#pragma unroll
    for (int dvb = 0; dvb < 2; ++dvb)
#pragma unroll
        for (int g = 0; g < 4; ++g) {
            u32x2 w = {pk2(O[dvb][4 * g], O[dvb][4 * g + 1]), pk2(O[dvb][4 * g + 2], O[dvb][4 * g + 3])};
            *(u32x2*)(dst + dvb * 32 + 8 * g + 4 * hh) = w;
        }
}

template <int GW>
DI float norm_rope(float v, const float* __restrict__ gain, const f32x2* __restrict__ rope_tok, int nrot, int ra, int lane) {
    float ss = v * v;
    ss = (GW == 64) ? wsum(ss) : sum32(ss);
    const int j = lane & (GW - 1);
    float y = v * rsqrtf(ss * (1.f / GW) + EPS) * gain[j];
    if (nrot) {
        const int half = nrot >> 1;
        const float partner = __shfl_xor(y, half);
        if (j < nrot) {
            const f32x2 cs = rope_tok[ra + (j & (half - 1))];
            y = (j < half) ? (y * cs[0] - partner * cs[1]) : (y * cs[0] + partner * cs[1]);
        }
    }
    return y;
}

DI bool xcd_unit(int k, int R, int ntn, int& tmg, int& tn) {
    const int x = blockIdx.x & 7, j = (int)(blockIdx.x >> 3) + k * (int)(gridDim.x >> 3);
    if (j >= R * ntn) return false;
    const int g0 = (R + 1) >> 1;
    int w = j, r0 = 0, gs = g0;
    if (j >= g0 * ntn) { w = j - g0 * ntn; r0 = g0; gs = R - g0; }
    tn = w / gs; tmg = x * R + r0 + (w - tn * gs);
    return true;
}

DI unsigned xb_ld(unsigned* p) { return __hip_atomic_load(p, __ATOMIC_RELAXED, __HIP_MEMORY_SCOPE_AGENT); }
DI unsigned xb_add(unsigned* p, unsigned v) { return __hip_atomic_fetch_add(p, v, __ATOMIC_RELAXED, __HIP_MEMORY_SCOPE_AGENT); }
DI unsigned xcc_id() { return (unsigned)__builtin_amdgcn_s_getreg((3 << 11) | 20) & 0xFu; }
DI void xbar(unsigned* bar, unsigned x, unsigned nloc, unsigned nx, int tid) {
    asm volatile("s_waitcnt vmcnt(0)" ::: "memory");
    __syncthreads();
    if (tid == 0) {
        __builtin_amdgcn_s_waitcnt(0);
        const unsigned old = xb_add(&bar[1024 + 64 * x], 1u);
        const unsigned gen = old / nloc;
        if (old + 1u == (gen + 1u) * nloc) {
            __builtin_amdgcn_fence(__ATOMIC_RELEASE, "agent");
            asm volatile("s_waitcnt vmcnt(0)" ::: "memory");
            const unsigned og = xb_add(&bar[3072], 1u);
            const unsigned tg = og / nx;
            if (og + 1u == (tg + 1u) * nx) xb_add(&bar[3136], 1u);
            else while (xb_ld(&bar[3136]) == tg) __builtin_amdgcn_s_sleep(1);
            __builtin_amdgcn_fence(__ATOMIC_ACQUIRE, "agent");
            xb_add(&bar[2048 + 64 * x], 1u);
            asm volatile("s_waitcnt vmcnt(0)" ::: "memory");
        } else {
            while (xb_ld(&bar[2048 + 64 * x]) == gen) __builtin_amdgcn_s_sleep(1);
            __builtin_amdgcn_fence(__ATOMIC_ACQUIRE, "agent");
            asm volatile("s_waitcnt vmcnt(0)" ::: "memory");
        }
    }
    __syncthreads();
}

__global__ void __launch_bounds__(NT, 2) mega(Params p) {
    extern __shared__ __attribute__((aligned(16))) unsigned char smem[];
    cg::grid_group grid = cg::this_grid();
    bool probe_second = false;
    int nbar = 0;
    unsigned* xbw = (unsigned*)(p.ws + WS_BAR);
    const unsigned xcc = (unsigned)__builtin_amdgcn_readfirstlane((int)xcc_id());
    unsigned xb_nloc = 1u, xb_nx = 1u;
    if (threadIdx.x == 0) xb_add(&xbw[64 * xcc], 1u);
    const int wave_s = __builtin_amdgcn_readfirstlane((int)(threadIdx.x >> 6));
    for (int ph = p.ph_lo; ph < p.ph_hi; ++ph) {
        int zop = 0; asm volatile("" : "+s"(zop));
        const int tid = wave_s * 64 + (int)__builtin_amdgcn_mbcnt_hi(~0u, __builtin_amdgcn_mbcnt_lo(~0u, (unsigned)zop));
        if (ph > p.ph_lo || probe_second) {
            if (nbar == 0) {
                grid.sync();
                unsigned cnt = 0u, mine = 1u;
                for (unsigned j = 0; j < 16; ++j) { const unsigned c = xb_ld(&xbw[64 * j]); cnt += (c > 0u) ? 1u : 0u; if (j == xcc) mine = c; }
                xb_nloc = (unsigned)__builtin_amdgcn_readfirstlane((int)(mine > 0u ? mine : 1u));
                xb_nx = (unsigned)__builtin_amdgcn_readfirstlane((int)(cnt > 0u ? cnt : 1u));
            } else xbar(xbw, xcc, xb_nloc, xb_nx, tid);
            ++nbar;
        }
        const int lane = tid & 63, wave = __builtin_amdgcn_readfirstlane(tid >> 6), r32 = lane & 31, hh = lane >> 5;
        const int wr = wave >> 1, wc = wave & 1;
        unsigned char* ws = p.ws;
        unsigned* ctr = (unsigned*)(ws + WS_CTR);
        float* modb = (float*)(ws + WS_MOD);
        f32x2* rope = (f32x2*)(ws + WS_ROPE);
        bf16_t* Wb = (bf16_t*)(ws + WS_W);
        bf16_t* w_in_t = (bf16_t*)(ws + WS_W + W_IN);
        bf16_t* w_g_t = (bf16_t*)(ws + WS_W + W_G);
        bf16_t* w_br_t = (bf16_t*)(ws + WS_W + W_BR);
        bf16_t* w_o_t = (bf16_t*)(ws + WS_W + W_O);
        bf16_t* w_up_t = (bf16_t*)(ws + WS_W + W_UP);
        bf16_t* w_dn_t = (bf16_t*)(ws + WS_W + W_DN);
        bf16_t* w_uq_t = (bf16_t*)(ws + WS_W + W_UQ);
        bf16_t* w_ukv_t = (bf16_t*)(ws + WS_W + W_UKV);
        (void)Wb;
        bf16_t* hbuf = (bf16_t*)(ws + WS_H);
        float* parts = (float*)(ws + WS_R1);
        bf16_t* gates = (bf16_t*)(ws + WS_R1 + R1_GATES);
        bf16_t* obuf = (bf16_t*)(ws + WS_R1 + R1_OBUF);
        bf16_t* abuf = (bf16_t*)(ws + WS_R1 + R1_ABUF);
        unsigned char* r2 = ws + WS_R2;
        bf16_t* qnsa = (bf16_t*)(r2 + R2_QNSA);
        float* qfnsa = (float*)(r2 + R2_QFNSA);
        bf16_t* ksb = (bf16_t*)(r2 + R2_KS);
        bf16_t* kwb = (bf16_t*)(r2 + R2_KW);
        bf16_t* vts = (bf16_t*)(r2 + R2_VTS);
        bf16_t* vtw = (bf16_t*)(r2 + R2_VTW);
        float* gn = (float*)(r2 + R2_GN);
        float* kcmp = (float*)(r2 + R2_KCMP);
        float* vcmp = (float*)(r2 + R2_VCMP);
        float* ocmp = (float*)(r2 + R2_OCMP);
        unsigned* selm = (unsigned*)(r2 + R2_SELM);
        bf16_t* fq = (bf16_t*)(r2 + R2_FQ);
        bf16_t* fk = (bf16_t*)(r2 + R2_FK);
        bf16_t* fvt = (bf16_t*)(r2 + R2_FVT);
        float* cumb = (float*)(r2 + R2_CUM);
        bf16_t* mq = (bf16_t*)(r2 + R2_MQ);
        bf16_t* mk = (bf16_t*)(r2 + R2_MK);
        bf16_t* mvt = (bf16_t*)(r2 + R2_MVT);
        bf16_t* dq = (bf16_t*)(r2 + R2_DQ);
        bf16_t* dkb = (bf16_t*)(r2 + R2_DK);
        bf16_t* dvt = (bf16_t*)(r2 + R2_DVT);
        float* dtmp = (float*)(r2 + R2_DTMP);
        float* ntmp = (float*)(r2 + R2_NTMP);

        const float* x_in = p.in[0];
        const float* c_in = p.in[1];
        const int* pos_in = (const int*)p.in[2];
        float* xo = p.out;

        if (ph == 0) {
            if (!EN(0)) continue;
            if (blockIdx.x == 0 && tid < 16) ctr[tid] = 0u;
            for (int idx = blockIdx.x * NT + tid; idx < M * 28; idx += gridDim.x * NT) {
                const int tok = idx / 28, a = idx % 28;
                float e;
                if (a < 8) e = -(float)a / 8.f; else if (a < 24) e = -(float)(a - 8) / 16.f; else e = -(float)(a - 24) / 4.f;
                const float inv_freq = powf(500000.f, e);
                const float ang = (float)pos_in[tok] * inv_freq;
                rope[idx] = (f32x2){cosf(ang), sinf(ang)};
            }
            float* sc = (float*)smem;
            float* red = sc + 8 * 1024;
            for (int i = tid; i < 8192; i += NT) sc[i] = siluf_(c_in[i]);
            __syncthreads();
            for (int job = blockIdx.x; job < NL * 96; job += gridDim.x) {
                const int l = job / 96, cgp = job % 96;
                const int kq = tid >> 6, j = tid & 63, col = cgp * 64 + j;
                float acc[8];
#pragma unroll
                for (int b = 0; b < 8; ++b) acc[b] = 0.f;
                const float* wp = p.in[3] + ((size_t)l * 1024 + kq * 256) * 6144 + col;
                for (int k = 0; k < 256; ++k) {
                    const float w = wp[(size_t)k * 6144];
#pragma unroll
                    for (int b = 0; b < 8; ++b) acc[b] += sc[b * 1024 + kq * 256 + k] * w;
                }
#pragma unroll
                for (int b = 0; b < 8; ++b) red[(kq * 8 + b) * 64 + j] = acc[b];
                __syncthreads();
                if (kq == 0) {
#pragma unroll
                    for (int b = 0; b < 8; ++b) {
                        const float v = red[(0 * 8 + b) * 64 + j] + red[(1 * 8 + b) * 64 + j] + red[(2 * 8 + b) * 64 + j] + red[(3 * 8 + b) * 64 + j];
                        modb[((size_t)l * 8 + b) * 6144 + col] = v + p.in[4][l * 6144 + col];
                    }
                }
                __syncthreads();
            }
            if (PROBE_SUB == 100 && !probe_second) { probe_second = true; --ph; } else probe_second = false;
            continue;
        }
        const int l = (ph - 1) / 10, sub = (ph - 1) % 10;
        const float* xcur = (l == 0) ? x_in : xo;
        const float* modl = modb + (size_t)l * 8 * 6144;
        if ((sub == 0 || sub == 7) && EN(1)) {
            if (sub == 0) {
                float* tsm = (float*)smem;
                tc_matrix(p.in[5] + (size_t)l * 1024 * NIN, 1024, NIN, w_in_t, 1024, tsm, 0, tid);
                for (int i = blockIdx.x * NT + tid; i < 64 * 1024 / 8; i += gridDim.x * NT) ((u32x4*)(w_in_t + (size_t)2624 * 1024))[i] = (u32x4){0u, 0u, 0u, 0u};
                tc_matrix(p.in[21] + (size_t)l * 1024 * 4096, 1024, 4096, w_g_t, 1024, tsm, 0, tid);
                tc_matrix(p.in[20] + (size_t)l * 1024 * 1024, 1024, 1024, w_br_t, 1024, tsm, 0, tid);
                tc_matrix(p.in[23] + (size_t)l * 1024 * 1024, 1024, 1024, w_o_t, 1024, tsm, 0, tid);
                tc_matrix(p.in[24] + (size_t)l * 1024 * 5632, 1024, 5632, w_up_t, 1024, tsm, 1, tid);
                tc_matrix(p.in[27] + (size_t)l * DFF * 1024, DFF, 1024, w_dn_t, DFF, tsm, 0, tid);
                tc_matrix(p.in[14] + (size_t)l * 256 * 384, 256, 384, w_uq_t, 256, tsm, 0, tid);
                tc_matrix(p.in[15] + (size_t)l * 128 * 512, 128, 512, w_ukv_t, 128, tsm, 0, tid);
            }
            const float* xs = (sub == 0) ? xcur : xo;
            const int osh = (sub == 0) ? 0 : 3072, osc = osh + 1024;
            for (int tok = blockIdx.x * 4 + wave; tok < M; tok += gridDim.x * 4) {
                const int b = tok / S;
                const f32x4* xr = (const f32x4*)(xs + (size_t)tok * D);
                f32x4 v[4]; float ss = 0.f;
#pragma unroll
                for (int i = 0; i < 4; ++i) { v[i] = xr[lane + 64 * i]; ss += v[i][0] * v[i][0] + v[i][1] * v[i][1] + v[i][2] * v[i][2] + v[i][3] * v[i][3]; }
                ss = wsum(ss);
                const float rstd = rsqrtf(ss * (1.f / D) + EPS);
                const float* mb = modl + (size_t)b * 6144;
#pragma unroll
                for (int i = 0; i < 4; ++i) {
                    const int col = (lane + 64 * i) * 4;
                    const f32x4 scv = *(const f32x4*)(mb + osc + col), shv = *(const f32x4*)(mb + osh + col);
                    float o[4];
#pragma unroll
                    for (int e = 0; e < 4; ++e) o[e] = v[i][e] * rstd * (1.f + scv[e]) + shv[e];
                    *(u32x2*)(hbuf + (size_t)tok * D + col) = (u32x2){pk2(o[0], o[1]), pk2(o[2], o[3])};
                }
            }
        } else if (sub == 1 && EN(2)) {
            const int ntn = NINP / 128;
            for (int k = 0;; ++k) {
                int tm, tn; if (!xcd_unit(k, 16, ntn, tm, tn)) break;
                f32x16 acc[2][2]; zero_acc(acc);
                gemm_main<2>(hbuf, D, RowPlain{tm * 128}, w_in_t, D, tn * 128, D / 64, acc, smem, NoHook{}, tid);
#pragma unroll
                for (int mt = 0; mt < 2; ++mt)
#pragma unroll
                    for (int nt = 0; nt < 2; ++nt)
#pragma unroll
                        for (int i = 0; i < 16; ++i) {
                            const int row = tm * 128 + wr * 64 + mt * 32 + crow(i, hh), col = tn * 128 + wc * 64 + nt * 32 + r32;
                            parts[(size_t)row * NINP + col] = acc[mt][nt][i];
                        }
            }
        } else if (sub == 2 && EN(3)) {
            const int NJ_MLA = 2 * (M / 64), NJ_CMP = NB * 2 * 32, NJ_TC = 10 * (M / 256), NJ_TOK = M / 32, NJ_CUM = 8;
            const int NJ = NJ_MLA + NJ_CMP + NJ_TC + NJ_TOK + NJ_CUM;
            unsigned* sj = (unsigned*)(smem + LDS_BYTES - 16);
            for (;;) {
                __syncthreads();
                if (tid == 0) *sj = atomicAdd(&ctr[16 + l + (probe_second ? 4 : 0)], 1u);
                __syncthreads();
                const int job = __builtin_amdgcn_readfirstlane((int)*sj);
                if (job >= NJ) break;
                int jj = job;
                if (jj < NJ_CUM) {
                {
                    const int bh = jj * 4 + wave, b = bh >> 2, hd = bh & 3;
                    const float fb = p.in[11][l * 4 + hd];
                    float vals[32]; float run = 0.f;
#pragma unroll
                    for (int i = 0; i < 32; ++i) {
                        const int t = lane * 32 + i;
                        const float xv = parts[(size_t)(b * S + t) * NINP + 1420 + hd] + fb;
                        const float ls = fminf(xv, 0.f) - log1pf(__expf(-fabsf(xv)));
                        run += ls; vals[i] = run;
                    }
                    float incl = run;
#pragma unroll
                    for (int o = 1; o < 64; o <<= 1) { const float v = __shfl_up(incl, o); if (lane >= o) incl += v; }
                    const float off = incl - run;
#pragma unroll
                    for (int i = 0; i < 32; ++i) cumb[(size_t)bh * S + lane * 32 + i] = off + vals[i];
                }
                    continue;
                }
                jj -= NJ_CUM;
                if (jj < NJ_MLA + NJ_CMP) {
                    const int seg = jj >> 8, off = jj & 255;
                    jj = (seg & 1) ? NJ_MLA + (seg >> 1) * 256 + off : (seg >> 1) * 256 + off;
                }
                if (jj < NJ_MLA) {
                    const bool doq = jj < (M / 64);
                    const int tok0 = (jj & (M / 64 - 1)) * 64, b = tok0 / S, t0 = tok0 % S;
                    bf16_t* aq = (bf16_t*)smem;
                    bf16_t* akv = aq + 64 * 264;
                    float* kr = (float*)(akv + 64 * 136);
                    float* krss = kr + 64 * 32;
                    float* rkk = krss + 64;
                    if (doq) {
                        const f32x4 g = *(const f32x4*)(p.in[12] + l * 256 + lane * 4);
#pragma unroll 1
                        for (int rb = wave * 16; rb < wave * 16 + 16; rb += 8) {
                            f32x4 v[8];
#pragma unroll
                            for (int k = 0; k < 8; ++k) v[k] = *(const f32x4*)(parts + (size_t)(tok0 + rb + k) * NINP + 1424 + lane * 4);
#pragma unroll
                            for (int k = 0; k < 8; ++k) {
                                const float ss = wsum(v[k][0] * v[k][0] + v[k][1] * v[k][1] + v[k][2] * v[k][2] + v[k][3] * v[k][3]);
                                const float rstd = rsqrtf(ss * (1.f / 256.f) + EPS);
                                *(u32x2*)(aq + (rb + k) * 264 + lane * 4) = (u32x2){pk2(v[k][0] * rstd * g[0], v[k][1] * rstd * g[1]), pk2(v[k][2] * rstd * g[2], v[k][3] * rstd * g[3])};
                            }
                        }
                    } else {
                        const f32x2 g2 = *(const f32x2*)(p.in[13] + l * 128 + lane * 2);
#pragma unroll 1
                        for (int rb = wave * 16; rb < wave * 16 + 16; rb += 8) {
                            f32x2 w[8]; float kvv[8];
#pragma unroll
                            for (int k = 0; k < 8; ++k) {
                                const float* pr = parts + (size_t)(tok0 + rb + k) * NINP;
                                w[k] = *(const f32x2*)(pr + 1680 + lane * 2);
                                kvv[k] = (lane < 32) ? pr[1808 + lane] : 0.f;
                            }
#pragma unroll
                            for (int k = 0; k < 8; ++k) {
                                const int r = rb + k;
                                const float ss = wsum(w[k][0] * w[k][0] + w[k][1] * w[k][1]);
                                const float rstd = rsqrtf(ss * (1.f / 128.f) + EPS);
                                *(unsigned*)(akv + r * 136 + lane * 2) = pk2(w[k][0] * rstd * g2[0], w[k][1] * rstd * g2[1]);
                                if (lane < 32) kr[r * 32 + lane] = kvv[k];
                                const float s2 = wsum(kvv[k] * kvv[k]);
                                if (lane == 0) krss[r] = s2;
                            }
                        }
                    }
                    __syncthreads();
                    const float* gq = p.in[16] + (size_t)l * 192;
                    const float* gk = gq + 96;
                    if (doq) {
#pragma unroll 1
                        for (int mt = 0; mt < 2; ++mt) {
                            f32x16 acc[3];
#pragma unroll
                            for (int c = 0; c < 3; ++c)
#pragma unroll
                                for (int i = 0; i < 16; ++i) acc[c][i] = 0.f;
#pragma unroll 8
                            for (int ks = 0; ks < 16; ++ks) {
                                const bf16x8 a0 = *(const bf16x8*)(aq + (mt * 32 + r32) * 264 + ks * 16 + hh * 8);
#pragma unroll
                                for (int nt = 0; nt < 3; ++nt) {
                                    const bf16x8 bb = *(const bf16x8*)(w_uq_t + (size_t)(wave * 96 + nt * 32 + r32) * 256 + ks * 16 + hh * 8);
                                    acc[nt] = MFMA32(a0, bb, acc[nt]);
                                }
                            }
                            const float gq0 = gq[r32], gq1 = gq[32 + r32], gq2 = gq[64 + r32];
#pragma unroll
                            for (int i = 0; i < 16; ++i) {
                                float ss = acc[0][i] * acc[0][i] + acc[1][i] * acc[1][i] + acc[2][i] * acc[2][i];
                                ss = sum32(ss);
                                const float rstd = rsqrtf(ss * (1.f / 96.f) + EPS);
                                const int row = mt * 32 + crow(i, hh), tok = tok0 + row;
                                float y0 = acc[0][i] * rstd * gq0;
                                const float y1 = acc[1][i] * rstd * gq1, y2 = acc[2][i] * rstd * gq2;
                                const float partner = __shfl_xor(y0, 16);
                                const f32x2 cs = rope[(size_t)tok * 28 + 8 + (r32 & 15)];
                                y0 = (r32 < 16) ? (y0 * cs[0] - partner * cs[1]) : (y0 * cs[0] + partner * cs[1]);
                                bf16_t* d = mq + (size_t)tok * 384 + wave * 96 + r32;
                                d[0] = f2bf(y0); d[32] = f2bf(y1); d[64] = f2bf(y2);
                                if ((i & 3) == 3) __builtin_amdgcn_sched_barrier(0);
                            }
                        }
                    }
                    if (!doq) {
#pragma unroll 1
                        for (int mt = 0; mt < 2; ++mt) {
                            f32x16 acc[4];
#pragma unroll
                            for (int c = 0; c < 4; ++c)
#pragma unroll
                                for (int i = 0; i < 16; ++i) acc[c][i] = 0.f;
#pragma unroll 8
                            for (int ks = 0; ks < 8; ++ks) {
                                const bf16x8 a0 = *(const bf16x8*)(akv + (mt * 32 + r32) * 136 + ks * 16 + hh * 8);
#pragma unroll
                                for (int nt = 0; nt < 4; ++nt) {
                                    const bf16x8 bb = *(const bf16x8*)(w_ukv_t + (size_t)(wave * 128 + nt * 32 + r32) * 128 + ks * 16 + hh * 8);
                                    acc[nt] = MFMA32(a0, bb, acc[nt]);
                                }
                            }
#pragma unroll
                            for (int i = 0; i < 16; ++i) {
                                const int row = mt * 32 + crow(i, hh), tok = tok0 + row;
                                float ss = acc[0][i] * acc[0][i] + acc[1][i] * acc[1][i];
                                ss = sum32(ss) + krss[row];
                                const float rstd = rsqrtf(ss * (1.f / 96.f) + EPS);
                                if (r32 == 0) rkk[row * 4 + wave] = rstd;
                                bf16_t* d = mk + (size_t)tok * 384 + wave * 96 + 32 + r32;
                                d[0] = f2bf(acc[0][i] * rstd * gk[32 + r32]);
                                d[32] = f2bf(acc[1][i] * rstd * gk[64 + r32]);
                            }
#pragma unroll
                            for (int nt = 2; nt < 4; ++nt)
#pragma unroll
                                for (int g = 0; g < 4; ++g) {
                                    const int dv = (nt - 2) * 32 + r32, tt = t0 + mt * 32 + 8 * g + 4 * hh;
                                    u32x2 w = {pk2(acc[nt][4 * g], acc[nt][4 * g + 1]), pk2(acc[nt][4 * g + 2], acc[nt][4 * g + 3])};
                                    *(u32x2*)(mvt + ((size_t)(b * 4 + wave) * 64 + dv) * S + tt) = w;
                                }
                        }
                    }
                    __syncthreads();
                    if (!doq)
                    for (int it = tid; it < 64 * 4 * 16; it += NT) {
                        const int row = it >> 6, hd = (it >> 4) & 3, j = it & 15, tok = tok0 + row;
                        const float rstd = rkk[row * 4 + hd];
                        const float x1 = kr[row * 32 + j] * rstd * gk[j], x2 = kr[row * 32 + 16 + j] * rstd * gk[16 + j];
                        const f32x2 cs = rope[(size_t)tok * 28 + 8 + j];
                        bf16_t* d = mk + (size_t)tok * 384 + hd * 96;
                        d[j] = f2bf(x1 * cs[0] - x2 * cs[1]);
                        d[16 + j] = f2bf(x2 * cs[0] + x1 * cs[1]);
                    }
                    __syncthreads();
                    continue;
                }
                jj -= NJ_MLA;
                if (jj < NJ_CMP) {
                    const int b = jj / 64, which = (jj / 32) & 1, c0 = (jj & 31) * 4;
                    float* B4 = (float*)smem;
                    float* red = B4 + 4 * 2048;
                    float* hid = red + 4 * 4 * 64;
                    const int colb = which ? 320 : 256;
                    const float* pe = p.in[7] + ((size_t)l * 2 + which) * 2048;
                    const float* w1 = p.in[8] + ((size_t)l * 2 + which) * 2048 * 64;
                    const float* w2 = p.in[9] + ((size_t)l * 2 + which) * 64 * 64;
#pragma unroll 1
                    for (int i0 = 0; i0 < 4 * 2048; i0 += 8 * NT) {
                        float xv[8], pv[8];
#pragma unroll
                        for (int k = 0; k < 8; ++k) {
                            const int i = i0 + k * NT + tid, ci = i >> 11, ii = i & 2047, pos = ii >> 6, d = ii & 63, t = (c0 + ci) * 16 + pos;
                            xv[k] = (t < S) ? parts[(size_t)(b * S + t) * NINP + colb + d] : 0.f; pv[k] = pe[ii];
                        }
#pragma unroll
                        for (int k = 0; k < 8; ++k) B4[i0 + k * NT + tid] = xv[k] + pv[k];
                    }
                    __syncthreads();
                    {
                        float a0 = 0.f, a1 = 0.f, a2 = 0.f, a3 = 0.f;
                        const float* wp = w1 + (size_t)(wave * 512) * 64 + lane;
                        const float* bp = B4 + wave * 512;
#pragma unroll 8
                        for (int i4 = 0; i4 < 128; ++i4) {
                            const f32x4 x0 = *(const f32x4*)(bp + i4 * 4), x1 = *(const f32x4*)(bp + 2048 + i4 * 4);
                            const f32x4 x2 = *(const f32x4*)(bp + 4096 + i4 * 4), x3 = *(const f32x4*)(bp + 6144 + i4 * 4);
#pragma unroll
                            for (int e = 0; e < 4; ++e) {
                                const float wv = wp[(size_t)(i4 * 4 + e) * 64];
                                a0 = fmaf(x0[e], wv, a0); a1 = fmaf(x1[e], wv, a1); a2 = fmaf(x2[e], wv, a2); a3 = fmaf(x3[e], wv, a3);
                            }
                        }
                        red[(wave * 4 + 0) * 64 + lane] = a0; red[(wave * 4 + 1) * 64 + lane] = a1;
                        red[(wave * 4 + 2) * 64 + lane] = a2; red[(wave * 4 + 3) * 64 + lane] = a3;
                    }
                    __syncthreads();
                    {
                        const int ci = wave, j = lane, c = c0 + ci;
                        const float hsum = red[(0 * 4 + ci) * 64 + j] + red[(1 * 4 + ci) * 64 + j] + red[(2 * 4 + ci) * 64 + j] + red[(3 * 4 + ci) * 64 + j];
                        hid[ci * 64 + j] = siluf_(hsum);
                        __syncthreads();
                        float o = 0.f;
#pragma unroll 16
                        for (int i = 0; i < 64; ++i) o += hid[ci * 64 + i] * w2[i * 64 + j];
                        if (which == 0) {
                            const float ss = wsum(o * o);
                            o = o * rsqrtf(ss * (1.f / 64.f) + EPS) * p.in[6][(size_t)l * 256 + 64 + j];
                        }
                        if (c < 127) (which ? vcmp : kcmp)[((size_t)b * 128 + c) * 64 + j] = o;
                    }
                    __syncthreads();
                    continue;
                }
                jj -= NJ_CMP;
                if (jj < 1024) {
                    const int seg = jj >> 8, off = jj & 255;
                    jj = (seg & 1) ? NJ_TC + (seg >> 1) * 256 + off : (seg >> 1) * 256 + off;
                } else jj -= 512;
                if (jj < NJ_TC) {
                    const int ct = jj / (M / 256), tt4 = jj % (M / 256);
                    const int tok0 = tt4 * 256, b = tok0 / S, t0 = tok0 % S;
                    int col; bf16_t* dst;
                    if (ct == 0) { col = 448; dst = vts + (size_t)b * 64 * S; }
                    else if (ct == 1) { col = 576; dst = vtw + (size_t)b * 64 * S; }
                    else if (ct < 6) { col = 1164 + (ct - 2) * 64; dst = fvt + (size_t)(b * 4 + ct - 2) * 64 * S; }
                    else { col = 2352 + (ct - 6) * 64; dst = dvt + (size_t)(b * 4 + ct - 6) * 64 * S; }
#pragma unroll 1
                    for (int k4 = 0; k4 < 4; ++k4) tc_tile(parts + (size_t)b * S * NINP, NINP, NINP, t0 + k4 * 64, col, dst, S, 0, (float*)smem, tid);
                    continue;
                }
                jj -= NJ_TC;
                if (jj < NJ_TOK) {
#pragma unroll 1
                    for (int ti = 0; ti < 8; ++ti) {
                    const int tok = jj * 32 + wave * 8 + ti;
                    const float* pr = parts + (size_t)tok * NINP;
                    const f32x2* rt = rope + (size_t)tok * 28;
                    const float* ng = p.in[6] + (size_t)l * 256;
                    float vq[4], vfq[4], vfk[4], vdq[4], vdk[4];
#pragma unroll
                    for (int hd = 0; hd < 4; ++hd) {
                        vq[hd] = pr[hd * 64 + lane]; vfq[hd] = pr[652 + hd * 64 + lane]; vfk[hd] = pr[908 + hd * 64 + lane];
                        vdq[hd] = pr[1840 + hd * 64 + lane]; vdk[hd] = pr[2096 + hd * 64 + lane];
                    }
                    const float vks = pr[384 + lane], vkw = pr[512 + lane], vg = (lane < 12) ? pr[640 + lane] : 0.f;
#pragma unroll
                    for (int hd = 0; hd < 4; ++hd) {
                        const float y = norm_rope<64>(vq[hd], ng, rt, 16, 0, lane);
                        qnsa[(size_t)tok * 256 + hd * 64 + lane] = f2bf(y);
                        qfnsa[(size_t)tok * 256 + hd * 64 + lane] = y;
                    }
                    ksb[(size_t)tok * 64 + lane] = f2bf(norm_rope<64>(vks, ng + 128, rt, 16, 0, lane));
                    kwb[(size_t)tok * 64 + lane] = f2bf(norm_rope<64>(vkw, ng + 192, rt, 16, 0, lane));
                    if (lane < 12) gn[(size_t)tok * 12 + lane] = sigmoidf_(vg);
                    const float* fg = p.in[10] + (size_t)l * 128;
#pragma unroll
                    for (int hd = 0; hd < 4; ++hd) {
                        fq[(size_t)tok * 256 + hd * 64 + lane] = f2bf(norm_rope<64>(vfq[hd], fg, rt, 0, 0, lane));
                        fk[(size_t)tok * 256 + hd * 64 + lane] = f2bf(norm_rope<64>(vfk[hd], fg + 64, rt, 0, 0, lane));
                    }
                    const float* dg = p.in[17] + (size_t)l * 64;
#pragma unroll
                    for (int hd = 0; hd < 4; ++hd) {
                        dq[(size_t)tok * 256 + hd * 64 + lane] = f2bf(norm_rope<32>(vdq[hd], dg, rt, 8, 24, lane));
                        dkb[(size_t)tok * 256 + hd * 64 + lane] = f2bf(norm_rope<32>(vdk[hd], dg + 32, rt, 8, 24, lane));
                    }
                    }
                    continue;
                }
            }
        } else if (sub == 3 && EN(4)) {
            const int NJ_C = M / 32;
            const int ntn = 4096 / 128;
            const int nrc = (NJ_C + (int)gridDim.x - 1) / (int)gridDim.x;
            for (int kk = 0;; ++kk) {
                const int job = (kk < nrc) ? (int)blockIdx.x + kk * (int)gridDim.x : NJ_C;
                if (kk < nrc && job >= NJ_C) continue;
                if (job < NJ_C) {
                    const int tokb = job * 32, b = tokb / S;
                    float* P = (float*)smem;
                    {
                        f32x4 k0[16], k1[16];
                        const f32x4* kp0 = (const f32x4*)(kcmp + ((size_t)b * 128 + lane) * 64);
                        const f32x4* kp1 = (const f32x4*)(kcmp + ((size_t)b * 128 + (lane < 63 ? lane + 64 : 126)) * 64);
#pragma unroll
                        for (int i = 0; i < 16; ++i) { k0[i] = kp0[i]; k1[i] = kp1[i]; }
#pragma unroll 1
                        for (int ti = 0; ti < 8; ++ti) {
                            const int tok = tokb + wave * 8 + ti, t = tok % S;
                            const int nvis = (t >= 31) ? ((t - 31) / 16 + 1) : 0;
                            const bool v0 = lane < nvis, v1 = (lane + 64) < nvis;
                            float imp = 0.f;
#pragma unroll
                            for (int hd = 0; hd < 4; ++hd) {
                                const float qv = qfnsa[(size_t)tok * 256 + hd * 64 + lane];
                                float s0 = 0.f, s1 = 0.f;
#pragma unroll
                                for (int d = 0; d < 64; ++d) {
                                    const float qd = __builtin_bit_cast(float, __builtin_amdgcn_readlane(__builtin_bit_cast(int, qv), d));
                                    s0 = fmaf(qd, k0[d >> 2][d & 3], s0); s1 = fmaf(qd, k1[d >> 2][d & 3], s1);
                                }
                                s0 = v0 ? s0 * 0.125f : -1e30f; s1 = v1 ? s1 * 0.125f : -1e30f;
                                const float mx = wmax(fmaxf(s0, s1));
                                const float e0 = v0 ? __expf(s0 - mx) : 0.f, e1 = v1 ? __expf(s1 - mx) : 0.f;
                                const float sm_ = wsum(e0 + e1);
                                const float inv = (nvis > 0) ? 1.f / sm_ : 0.f;
                                float* pr_ = P + (wave * 32 + ti * 4 + hd) * 128;
                                pr_[lane] = e0 * inv; pr_[lane + 64] = e1 * inv;
                            }
                            __syncthreads();
                            if (lane < 32) {
#pragma unroll
                                for (int hd = 0; hd < 4; ++hd) {
                                    const float* pr_ = P + (wave * 32 + ti * 4 + hd) * 128;
#pragma unroll
                                    for (int dc = -1; dc <= 3; ++dc) { const int c = 4 * lane + dc; if (c >= 0 && c <= 126) imp += pr_[c]; }
                                }
                            }
                            const int cur = t >> 6, j = lane;
                            float score;
                            if (j * 64 > t) score = -1.f;
                            else if (j == 0 || j == cur || j == cur - 1) score = 1e4f;
                            else score = imp;
                            if (j >= 32) score = -2.f;
                            int cnt = 0;
#pragma unroll
                            for (int i = 0; i < 32; ++i) {
                                const float si = __builtin_bit_cast(float, __builtin_amdgcn_readlane(__builtin_bit_cast(int, score), i));
                                cnt += (si > score || (si == score && i < j)) ? 1 : 0;
                            }
                            const bool sel = (j < 32) && (cnt < 16) && (j * 64 <= t);
                            const unsigned long long bal = __ballot(sel);
                            if (lane == 0) selm[tok] = (unsigned)bal;
                        }
                    }
                    __syncthreads();
                    {
                        float vcol[128];
#pragma unroll
                        for (int c = 0; c < 127; ++c) vcol[c] = vcmp[((size_t)b * 128 + c) * 64 + lane];
                        vcol[127] = 0.f;
#pragma unroll 1
                        for (int pi = 0; pi < 32; ++pi) {
                            const f32x4* pr_ = (const f32x4*)(P + (wave * 32 + pi) * 128);
                            float o0 = 0.f, o1 = 0.f;
#pragma unroll
                            for (int c4 = 0; c4 < 32; ++c4) {
                                const f32x4 pv = pr_[c4];
                                o0 = fmaf(pv[0], vcol[4 * c4], o0); o1 = fmaf(pv[1], vcol[4 * c4 + 1], o1);
                                o0 = fmaf(pv[2], vcol[4 * c4 + 2], o0); o1 = fmaf(pv[3], vcol[4 * c4 + 3], o1);
                            }
                            const int tok = tokb + wave * 8 + (pi >> 2), hd = pi & 3;
                            ocmp[(size_t)tok * 256 + hd * 64 + lane] = o0 + o1;
                        }
                    }
                    __syncthreads();
                } else break;
            }
        } else if (sub == 4 && EN(5)) {
            unsigned* su = (unsigned*)(smem + LDS_BYTES - 16);
            const float lam_init = __builtin_bit_cast(float, __builtin_amdgcn_readfirstlane(__builtin_bit_cast(int, 0.8f - 0.6f * expf(-0.3f * (float)l))));
            const float one_m_lam = __builtin_bit_cast(float, __builtin_amdgcn_readfirstlane(__builtin_bit_cast(int, 1.f - lam_init)));
            float lam;
            {
                const float* lv = p.in[18] + (size_t)l * 128;
                const int j = lane & 31;
                const float a1 = sum32(lv[j] * lv[32 + j]), a2 = sum32(lv[64 + j] * lv[96 + j]);
                lam = expf(a1) - expf(a2) + lam_init;
                lam = __builtin_bit_cast(float, __builtin_amdgcn_readfirstlane(__builtin_bit_cast(int, lam)));
            }
            const int role = (blockIdx.x >= (gridDim.x >> 1)) ? 1 : 0;
#pragma unroll 1
            for (int step = 0; step < 3; ++step) {
            const int what = role ? (step == 0 ? 2 : (step == 1 ? 1 : 0)) : (step == 0 ? 0 : (step == 1 ? 2 : 1));
            if (what == 2) {
            {
                const int ntn = 4096 / 128;
                for (int k = 0;; ++k) {
                    int tm, tn; if (!xcd_unit(k, 16, ntn, tm, tn)) break;
                    f32x16 acc[2][2]; zero_acc(acc);
                    gemm_main<2>(w_g_t, D, RowPlain{tn * 128}, hbuf, D, tm * 128, D / 64, acc, smem, NoHook{}, tid);
                    const int colb = tn * 128 + wr * 64 + 4 * hh, rowb = tm * 128 + wc * 64 + r32;
                    const float* gb = p.in[22] + (size_t)l * 4096 + colb;
                    bf16_t* gub = gates + (size_t)rowb * GLD + colb;
#pragma unroll
                    for (int mt = 0; mt < 2; ++mt)
#pragma unroll
                        for (int g = 0; g < 4; ++g) {
                            const f32x4 bv = *(const f32x4*)(gb + mt * 32 + 8 * g);
#pragma unroll
                            for (int nt = 0; nt < 2; ++nt) {
                                const float s0 = sigmoidf_(acc[mt][nt][4 * g + 0] + bv[0]), s1 = sigmoidf_(acc[mt][nt][4 * g + 1] + bv[1]);
                                const float s2 = sigmoidf_(acc[mt][nt][4 * g + 2] + bv[2]), s3 = sigmoidf_(acc[mt][nt][4 * g + 3] + bv[3]);
                                *(u32x2*)(gub + (size_t)(nt * 32) * GLD + mt * 32 + 8 * g) = (u32x2){pk2(s0, s1), pk2(s2, s3)};
                            }
                        }
                }
            }
            } else for (;;) {
                if (tid == 0) *su = atomicAdd(&ctr[l + 8 * what], 1u);
                __syncthreads();
                const unsigned u = (unsigned)__builtin_amdgcn_readfirstlane((int)*su);
                __syncthreads();
                if (u >= 1024u) break;
                const unsigned uu = 2u * u + (unsigned)what;
                const int qb = 15 - (int)(uu >> 7), rem = uu & 127, type = rem >> 5, bh = rem & 31, b = bh >> 2, hd = bh & 3;
                const int q0 = qb * 128;
                const bf16_t *Qa, *Ka, *Va, *Qb2, *Kb2, *Vb2; int qs, ksr, nks, mode0, mode1, npass; float scale; const float* cu = nullptr;
                if (type == 0) {
                    Qa = Qb2 = qnsa + (size_t)b * S * 256 + hd * 64; qs = 256; ksr = 64; nks = 4; scale = 0.125f; npass = 2; mode0 = 2; mode1 = 3;
                    Ka = ksb + (size_t)b * S * 64; Kb2 = kwb + (size_t)b * S * 64; Va = vts + (size_t)b * 64 * S; Vb2 = vtw + (size_t)b * 64 * S;
                } else if (type == 1) {
                    Qa = Qb2 = fq + (size_t)b * S * 256 + hd * 64; Ka = Kb2 = fk + (size_t)b * S * 256 + hd * 64; Va = Vb2 = fvt + (size_t)bh * 64 * S;
                    qs = 256; ksr = 256; nks = 4; scale = 0.125f; npass = 1; mode0 = mode1 = 1; cu = cumb + (size_t)bh * S;
                } else if (type == 2) {
                    Qa = Qb2 = mq + (size_t)b * S * 384 + hd * 96; Ka = Kb2 = mk + (size_t)b * S * 384 + hd * 96; Va = Vb2 = mvt + (size_t)bh * 64 * S;
                    qs = 384; ksr = 384; nks = 6; scale = 0.10206207261596577f; npass = 1; mode0 = mode1 = 0;
                } else {
                    Qa = dq + (size_t)b * S * 256 + hd * 64; Qb2 = Qa + 32; Ka = dkb + (size_t)b * S * 256 + hd * 64; Kb2 = Ka + 32; Va = Vb2 = dvt + (size_t)bh * 64 * S;
                    qs = 256; ksr = 256; nks = 2; scale = 0.17677669529663687f; npass = 2; mode0 = mode1 = 0;
                }
                f32x16 O[2];
#pragma nounroll
                for (int pass = 0; pass < npass; ++pass) {
                    attn_pass(pass ? Qb2 : Qa, qs, pass ? Kb2 : Ka, ksr, pass ? Vb2 : Va, cu, selm + (size_t)b * S, scale, nks, pass ? mode1 : mode0, q0, O, smem, wave, lane, tid);
                    if (npass == 2 && pass == 0) {
                        const size_t tok = (size_t)b * S + q0 + wave * 32 + r32;
                        float* tp = ((type == 0) ? ntmp : dtmp) + tok * 256 + hd * 64 + 4 * hh;
                        const float* ocp = ocmp + tok * 256 + hd * 64 + 4 * hh;
                        float g0 = 0.f, g1 = 0.f;
                        if (type == 0) { g0 = gn[tok * 12 + hd]; g1 = gn[tok * 12 + 4 + hd]; }
#pragma unroll
                        for (int dvb = 0; dvb < 2; ++dvb)
#pragma unroll
                            for (int g = 0; g < 4; ++g) {
                                f32x4 v = {O[dvb][4 * g], O[dvb][4 * g + 1], O[dvb][4 * g + 2], O[dvb][4 * g + 3]};
                                f32x4* a = (f32x4*)(tp + dvb * 32 + 8 * g);
                                if (type == 0) { const f32x4 oc = *(const f32x4*)(ocp + dvb * 32 + 8 * g); v = oc * g0 + v * g1; }
                                *a = v;
                            }
                    }
                }
                const int cbase = type * 256;
                const size_t tok = (size_t)b * S + q0 + wave * 32 + r32;
                const float* tp = ((type == 0) ? ntmp : dtmp) + tok * 256 + hd * 64 + 4 * hh;
                if (type == 0) {
                    const float g2 = gn[tok * 12 + 8 + hd];
#pragma unroll
                    for (int dvb = 0; dvb < 2; ++dvb)
#pragma unroll
                        for (int g = 0; g < 4; ++g) {
                            const f32x4 oc = *(const f32x4*)(tp + dvb * 32 + 8 * g);
#pragma unroll
                            for (int e = 0; e < 4; ++e) O[dvb][4 * g + e] = oc[e] + g2 * O[dvb][4 * g + e];
                        }
                } else if (type == 3) {
                    float ss = 0.f;
#pragma unroll
                    for (int dvb = 0; dvb < 2; ++dvb)
#pragma unroll
                        for (int g = 0; g < 4; ++g) {
                            const f32x4 oc = *(const f32x4*)(tp + dvb * 32 + 8 * g);
#pragma unroll
                            for (int e = 0; e < 4; ++e) { const float r = oc[e] - lam * O[dvb][4 * g + e]; O[dvb][4 * g + e] = r; ss += r * r; }
                        }
                    ss += __shfl_xor(ss, 32);
                    const float rstd = rsqrtf(ss * (1.f / 64.f) + EPS);
                    const float* og = p.in[19] + (size_t)l * 64;
#pragma unroll
                    for (int dvb = 0; dvb < 2; ++dvb)
#pragma unroll
                        for (int g = 0; g < 4; ++g) {
                            const f32x4 gg = *(const f32x4*)(og + dvb * 32 + 8 * g + 4 * hh);
#pragma unroll
                            for (int e = 0; e < 4; ++e) O[dvb][4 * g + e] *= rstd * (gg[e] * one_m_lam);
                        }
                }
                store_o(obuf + tok * 1024 + cbase + hd * 64, O, hh);
            }
            }
        } else if (sub == 5 && EN(6)) {
            const int ntn = D / 128;
            for (int k = 0;; ++k) {
                int tm, tn; if (!xcd_unit(k, 16, ntn, tm, tn)) break;
                f32x16 acc[2][2], mg[2][2]; zero_acc(acc); zero_acc(mg);
                const int colb = tn * 128 + wr * 64 + 4 * hh, rowb = tm * 128 + wc * 64 + r32;
                const bf16_t* gub = gates + (size_t)rowb * GLD + colb;
                auto hook = [&](int kt, f32x16 (&a)[2][2]) {
                    if ((kt & 3) == 3) {
                        const bf16_t* gu = gub + (kt >> 2) * 1024;
#pragma unroll
                        for (int mt = 0; mt < 2; ++mt)
#pragma unroll
                            for (int nt = 0; nt < 2; ++nt)
#pragma unroll
                                for (int g = 0; g < 4; ++g) {
                                    const u32x2 gv = *(const u32x2*)(gu + (size_t)(nt * 32) * GLD + mt * 32 + 8 * g);
                                    mg[mt][nt][4 * g + 0] += __uint_as_float(gv[0] << 16) * a[mt][nt][4 * g + 0];
                                    mg[mt][nt][4 * g + 1] += __uint_as_float(gv[0] & 0xffff0000u) * a[mt][nt][4 * g + 1];
                                    mg[mt][nt][4 * g + 2] += __uint_as_float(gv[1] << 16) * a[mt][nt][4 * g + 2];
                                    mg[mt][nt][4 * g + 3] += __uint_as_float(gv[1] & 0xffff0000u) * a[mt][nt][4 * g + 3];
                                    a[mt][nt][4 * g + 0] = 0.f; a[mt][nt][4 * g + 1] = 0.f; a[mt][nt][4 * g + 2] = 0.f; a[mt][nt][4 * g + 3] = 0.f;
                                }
                    }
                };
                gemm_main1<2>(w_br_t, D, RowPlain{tn * 128}, obuf, D, tm * 128, D / 64, acc, smem, hook, tid);
                bf16_t* hub = hbuf + (size_t)rowb * D + colb;
#pragma unroll
                for (int mt = 0; mt < 2; ++mt)
#pragma unroll
                    for (int nt = 0; nt < 2; ++nt)
#pragma unroll
                        for (int g = 0; g < 4; ++g) {
                            u32x2 w = {pk2(mg[mt][nt][4 * g], mg[mt][nt][4 * g + 1]), pk2(mg[mt][nt][4 * g + 2], mg[mt][nt][4 * g + 3])};
                            *(u32x2*)(hub + (size_t)(nt * 32) * D + mt * 32 + 8 * g) = w;
                        }
            }
        } else if ((sub == 6 || sub == 9) && EN(7)) {
            const int ntn = D / 128;
            const bf16_t* A = (sub == 6) ? hbuf : abuf;
            const int lda = (sub == 6) ? D : DFF;
            const bf16_t* Bt = (sub == 6) ? w_o_t : w_dn_t;
            const float* xs = (sub == 6) ? xcur : xo;
            const int og = (sub == 6) ? 2048 : 5120;
            for (int k = 0;; ++k) {
                int tm, tn; if (!xcd_unit(k, 16, ntn, tm, tn)) break;
                f32x16 acc[2][2]; zero_acc(acc);
                gemm_main<2>(A, lda, RowPlain{tm * 128}, Bt, lda, tn * 128, lda / 64, acc, smem, NoHook{}, tid);
                const float* mb = modl + (size_t)(tm * 128 / S) * 6144 + og;
#pragma unroll
                for (int mt = 0; mt < 2; ++mt)
#pragma unroll
                    for (int nt = 0; nt < 2; ++nt)
#pragma unroll
                        for (int i = 0; i < 16; ++i) {
                            const int row = tm * 128 + wr * 64 + mt * 32 + crow(i, hh), col = tn * 128 + wc * 64 + nt * 32 + r32;
                            xo[(size_t)row * D + col] = xs[(size_t)row * D + col] + mb[col] * acc[mt][nt][i];
                        }
            }
        } else if (sub == 8 && EN(8)) {
            const int ntn = 44, ntm = 17;
            const float* cw = p.in[25] + (size_t)l * 3 * DFF;
            const float* cb = p.in[26] + (size_t)l * DFF;
            float* gl = (float*)smem;
            for (int k = 0;; ++k) {
                int tmg, tn; if (!xcd_unit(k, ntm, ntn, tmg, tn)) break;
                const int b = tmg / ntm, tmm = tmg - b * ntm;
                const int t0 = tmm * 126 - 2;
                f32x16 acc[2][2]; zero_acc(acc);
                gemm_main<2>(hbuf, D, RowClamp{b * S, t0}, w_up_t, D, tn * 128, D / 64, acc, smem, NoHook{}, tid);
                {
                    float* wl = gl + (wr * 64 + 4 * hh) * 129 + wc * 64 + r32;
#pragma unroll
                    for (int mt = 0; mt < 2; ++mt)
#pragma unroll
                        for (int nt = 0; nt < 2; ++nt)
#pragma unroll
                            for (int i = 0; i < 16; ++i) wl[(mt * 32 + (i & 3) + 8 * (i >> 2)) * 129 + nt * 32] = acc[mt][nt][i];
                }
                __syncthreads();
                {
                    const int cc = tid & 63, rs = (tid >> 6) * 32, ch = tn * 64 + cc;
                    const float w0 = cw[ch], w1 = cw[DFF + ch], w2 = cw[2 * DFF + ch], bb = cb[ch];
                    float ga = 0.f, gb2 = 0.f;
                    if (rs >= 2) { ga = gl[(rs - 2) * 129 + cc]; gb2 = gl[(rs - 1) * 129 + cc]; }
                    bf16_t* ap = abuf + ((ptrdiff_t)(b * S + t0 + rs)) * DFF + ch;
#pragma unroll 4
                    for (int k = 0; k < 32; ++k) {
                        const int r = rs + k, t = t0 + r;
                        float gc = gl[r * 129 + cc];
                        if (t < 0) gc = 0.f;
                        const float vv = gl[r * 129 + 64 + cc];
                        if (r >= 2 && t < S) ap[(ptrdiff_t)k * DFF] = f2bf(siluf_(w0 * ga + w1 * gb2 + w2 * gc + bb) * vv);
                        ga = gb2; gb2 = gc;
                    }
                }
                __syncthreads();
            }
        }
        if (PROBE_SUB >= 0 || PROBE_MASK != 0u) { if ((sub == PROBE_SUB || ((PROBE_MASK >> sub) & 1u)) && !probe_second) { probe_second = true; --ph; } else probe_second = false; }
    }
}

extern "C" void kernel_launch(void* const* d_in, const int* in_sizes, int n_in, void* d_out, int out_size, void* d_ws, size_t ws_size, hipStream_t stream) {
    static int grid = 0;
    if (grid == 0) {
        if (n_in != 28 || ws_size < WS_END) { fprintf(stderr, "kernel_launch: bad inputs n_in %d ws %zu need %zu\n", n_in, ws_size, (size_t)WS_END); grid = -1; return; }
        int dev = 0, cus = 0, per_cu = 0;
        hipGetDevice(&dev);
        hipDeviceGetAttribute(&cus, hipDeviceAttributeMultiprocessorCount, dev);
        if (hipFuncSetAttribute((const void*)mega, hipFuncAttributeMaxDynamicSharedMemorySize, LDS_BYTES) != hipSuccess) { fprintf(stderr, "hipFuncSetAttribute failed\n"); grid = -1; return; }
        if (hipOccupancyMaxActiveBlocksPerMultiprocessor(&per_cu, (const void*)mega, NT, LDS_BYTES) != hipSuccess || per_cu < 1) { fprintf(stderr, "occupancy query failed\n"); per_cu = 1; }
        if (per_cu > 2) per_cu = 2;
        grid = cus * per_cu;
    }
    if (grid < 0) return;
    if (hipMemsetAsync((char*)d_ws + WS_CTR, 0, 256, stream) != hipSuccess) { fprintf(stderr, "memset failed\n"); return; }
    if (hipMemsetAsync((char*)d_ws + WS_BAR, 0, 16384, stream) != hipSuccess) { fprintf(stderr, "memset failed\n"); return; }
    Params p{};
    for (int i = 0; i < 28; ++i) p.in[i] = (const float*)d_in[i];
    p.out = (float*)d_out; p.ws = (unsigned char*)d_ws; p.ph_lo = 0; p.ph_hi = 1 + NL * 10;
    void* args[] = {&p};
    hipError_t e = hipLaunchCooperativeKernel((const void*)mega, dim3(grid), dim3(NT), args, LDS_BYTES, stream);
    if (e != hipSuccess) fprintf(stderr, "cooperative launch failed: %s (grid %d)\n", hipGetErrorString(e), grid);
}
```

```cpp
#include <hip/hip_runtime.h>
#include <hip/hip_cooperative_groups.h>
#include <stdint.h>
#include <stdio.h>
#include <math.h>
namespace cg = cooperative_groups;

typedef unsigned short bf16_t;
typedef short bf16x8 __attribute__((ext_vector_type(8)));
typedef short s16x4 __attribute__((ext_vector_type(4)));
typedef float f32x16 __attribute__((ext_vector_type(16)));
typedef float f32x4 __attribute__((ext_vector_type(4)));
typedef float f32x2 __attribute__((ext_vector_type(2)));
typedef unsigned u32x4 __attribute__((ext_vector_type(4)));
typedef unsigned u32x2 __attribute__((ext_vector_type(2)));
typedef __bf16 bfv2 __attribute__((ext_vector_type(2)));

#define DI __device__ __forceinline__
#define MFMA32(a, b, c) __builtin_amdgcn_mfma_f32_32x32x16_bf16((a), (b), (c), 0, 0, 0)

constexpr int NB = 8, S = 2048, D = 1024, M = NB * S, NL = 4;
constexpr int NIN = 2608, NINP = 2688, DFF = 2816;
constexpr float EPS = 1e-6f;
constexpr int NT = 256;

constexpr size_t al256(size_t x) { return (x + 255) & ~(size_t)255; }
constexpr size_t WS_CTR = 0;
constexpr size_t WS_MOD = 256;
constexpr size_t WS_ROPE = al256(WS_MOD + (size_t)NL * NB * 6144 * 4);
constexpr size_t WS_W = al256(WS_ROPE + (size_t)M * 28 * 8);
constexpr size_t W_IN = 0;
constexpr size_t W_G = W_IN + (size_t)NINP * 1024 * 2;
constexpr size_t W_BR = W_G + (size_t)4096 * 1024 * 2;
constexpr size_t W_O = W_BR + (size_t)1024 * 1024 * 2;
constexpr size_t W_UP = W_O + (size_t)1024 * 1024 * 2;
constexpr size_t W_DN = W_UP + (size_t)5632 * 1024 * 2;
constexpr size_t W_UQ = W_DN + (size_t)1024 * 2816 * 2;
constexpr size_t W_UKV = W_UQ + (size_t)384 * 256 * 2;
constexpr size_t W_END = W_UKV + (size_t)512 * 128 * 2;
constexpr size_t WS_H = al256(WS_W + W_END);
constexpr size_t WS_R1 = al256(WS_H + (size_t)M * 1024 * 2);
constexpr size_t R1_GATES = 0;
constexpr int GLD = 4160;
constexpr size_t R1_OBUF = (size_t)M * GLD * 2;
constexpr size_t R1_ABUF = 0;
constexpr size_t WS_R2 = al256(WS_R1 + (size_t)M * NINP * 4);
constexpr size_t R2_QNSA = 0;
constexpr size_t R2_QFNSA = R2_QNSA + (size_t)M * 256 * 2;
constexpr size_t R2_KS = R2_QFNSA + (size_t)M * 256 * 4;
constexpr size_t R2_KW = R2_KS + (size_t)M * 64 * 2;
constexpr size_t R2_VTS = R2_KW + (size_t)M * 64 * 2;
constexpr size_t R2_VTW = R2_VTS + (size_t)M * 64 * 2;
constexpr size_t R2_GN = R2_VTW + (size_t)M * 64 * 2;
constexpr size_t R2_KCMP = R2_GN + (size_t)M * 12 * 4;
constexpr size_t R2_VCMP = R2_KCMP + (size_t)NB * 128 * 64 * 4;
constexpr size_t R2_OCMP = R2_VCMP + (size_t)NB * 128 * 64 * 4;
constexpr size_t R2_SELM = R2_OCMP + (size_t)M * 256 * 4;
constexpr size_t R2_FQ = R2_SELM + (size_t)M * 4;
constexpr size_t R2_FK = R2_FQ + (size_t)M * 256 * 2;
constexpr size_t R2_FVT = R2_FK + (size_t)M * 256 * 2;
constexpr size_t R2_CUM = R2_FVT + (size_t)M * 256 * 2;
constexpr size_t R2_MQ = R2_CUM + (size_t)NB * 4 * S * 4;
constexpr size_t R2_MK = R2_MQ + (size_t)M * 384 * 2;
constexpr size_t R2_MVT = R2_MK + (size_t)M * 384 * 2;
constexpr size_t R2_DQ = R2_MVT + (size_t)M * 256 * 2;
constexpr size_t R2_DK = R2_DQ + (size_t)M * 256 * 2;
constexpr size_t R2_DVT = R2_DK + (size_t)M * 256 * 2;
constexpr size_t R2_DTMP = R2_DVT + (size_t)M * 256 * 2;
constexpr size_t R2_NTMP = R2_DTMP + (size_t)M * 256 * 4;
constexpr size_t R2_END = R2_NTMP + (size_t)M * 256 * 4;
constexpr size_t WS_BAR = al256(WS_R2 + R2_END);
constexpr size_t WS_END = WS_BAR + 16384;

constexpr int LDS_BYTES = 73728;
#ifndef PROBE_SUB
#define PROBE_SUB (-1)
#endif
#ifndef PROBE_MASK
#define PROBE_MASK 0u
#endif
#ifndef EN_MASK
#define EN_MASK 0xffffu
#endif
#define EN(k) ((EN_MASK >> (k)) & 1u)
#ifndef TY_MASK
#define TY_MASK 0xfu
#endif
#define TY(k) ((TY_MASK >> (k)) & 1u)

struct Params {
    const float* in[28];
    float* out;
    unsigned char* ws;
    int ph_lo, ph_hi;
};

DI unsigned pk2(float a, float b) { f32x2 v = {a, b}; bfv2 r = __builtin_convertvector(v, bfv2); return __builtin_bit_cast(unsigned, r); }
DI bf16_t f2bf(float a) { return (bf16_t)(pk2(a, 0.f) & 0xffffu); }
DI float bf2f(bf16_t v) { return __uint_as_float(((unsigned)v) << 16); }
template <int CTRL> DI float dpp_f(float v) { return __builtin_bit_cast(float, __builtin_amdgcn_update_dpp(0, __builtin_bit_cast(int, v), CTRL, 0xf, 0xf, true)); }
DI float sum16_dpp(float v) {
    v += dpp_f<0xB1>(v);
    v += dpp_f<0x4E>(v);
    v += dpp_f<0x141>(v);
    v += dpp_f<0x140>(v);
    return v;
}
DI float wsum(float v) {
    v = sum16_dpp(v);
    v += __shfl_xor(v, 16);
    v += __shfl_xor(v, 32);
    return v;
}
DI float wmax(float v) {
#pragma unroll
    for (int o = 1; o < 64; o <<= 1) v = fmaxf(v, __shfl_xor(v, o));
    return v;
}
DI float sum32(float v) {
    v = sum16_dpp(v);
    v += __shfl_xor(v, 16);
    return v;
}
DI float sigmoidf_(float x) { return __builtin_amdgcn_rcpf(1.f + __builtin_amdgcn_exp2f(-1.4426950408889634f * x)); }
DI float siluf_(float x) { return x * __builtin_amdgcn_rcpf(1.f + __builtin_amdgcn_exp2f(-1.4426950408889634f * x)); }
DI int crow(int i, int hh) { return (i & 3) + 8 * (i >> 2) + 4 * hh; }

DI void tc_tile(const float* __restrict__ src, int ld, int nvalid, int k0, int n0, bf16_t* __restrict__ dst, int ldd, int drow0, float* sm, int tid) {
#pragma unroll
    for (int p = 0; p < 4; ++p) {
        const int r = p * 16 + (tid >> 4), c4 = (tid & 15) * 4;
        f32x4 v = {0.f, 0.f, 0.f, 0.f};
        if (n0 + c4 < nvalid) v = *(const f32x4*)(src + (size_t)(k0 + r) * ld + n0 + c4);
        sm[r * 65 + c4 + 0] = v[0]; sm[r * 65 + c4 + 1] = v[1]; sm[r * 65 + c4 + 2] = v[2]; sm[r * 65 + c4 + 3] = v[3];
    }
    __syncthreads();
    const int n = tid >> 2, ks = (tid & 3) * 16;
    unsigned w[8];
#pragma unroll
    for (int i = 0; i < 8; ++i) w[i] = pk2(sm[(ks + 2 * i) * 65 + n], sm[(ks + 2 * i + 1) * 65 + n]);
    u32x4* d = (u32x4*)(dst + (size_t)(drow0 + n) * ldd + k0 + ks);
    d[0] = (u32x4){w[0], w[1], w[2], w[3]};
    d[1] = (u32x4){w[4], w[5], w[6], w[7]};
    __syncthreads();
}

DI void tc_matrix(const float* src, int K, int N, bf16_t* dst, int ldd, float* sm, int mode  , int tid) {
    const int nkt = K / 64, nnt = (N + 63) / 64;
    for (int j = blockIdx.x; j < nkt * nnt; j += gridDim.x) {
        const int tn = j / nkt, tk = j % nkt;
        int drow0 = tn * 64;
        if (mode == 1) drow0 = (tn < 44) ? tn * 128 : (tn - 44) * 128 + 64;
        tc_tile(src, N, N, tk * 64, tn * 64, dst, ldd, drow0, sm, tid);
    }
}

struct NoHook { template <class T> DI void operator()(int, T&) const {} };

template <int NTW, class AR, class HK>
DI void gemm_main(const bf16_t* __restrict__ A, int lda, AR arow, const bf16_t* __restrict__ Bt, int ldb, int col0, int nk,
                  f32x16 (&acc)[2][NTW], unsigned char* smraw, HK hook, int tid) {
    constexpr int BROWS = 64 * NTW, NBL = 2 * NTW;
    bf16_t* sa = (bf16_t*)smraw;
    bf16_t* sb = sa + 2 * 128 * 72;
    const int lane = tid & 63, wave = __builtin_amdgcn_readfirstlane(tid >> 6), wr = wave >> 1, wc = wave & 1, r32 = lane & 31, hh = lane >> 5;
    const int lr = tid >> 3, lc = (tid & 7) * 8;
    const bf16_t* ap[4];
    const bf16_t* bp[NBL];
#pragma unroll
    for (int p = 0; p < 4; ++p) ap[p] = A + (size_t)arow(p * 32 + lr) * lda + lc;
#pragma unroll
    for (int p = 0; p < NBL; ++p) bp[p] = Bt + (size_t)(col0 + p * 32 + lr) * ldb + lc;
    u32x4 ra0[4], rb0[NBL], ra1[4], rb1[NBL];
#define G_LOAD(RA, RB, KT) { _Pragma("unroll") for (int p = 0; p < 4; ++p) RA[p] = *(const u32x4*)(ap[p] + (KT) * 64); _Pragma("unroll") for (int p = 0; p < NBL; ++p) RB[p] = *(const u32x4*)(bp[p] + (KT) * 64); }
#define G_STORE(RA, RB, BUF) { bf16_t* wa = sa + (BUF) * 128 * 72; bf16_t* wb = sb + (BUF) * BROWS * 72; _Pragma("unroll") for (int p = 0; p < 4; ++p) *(u32x4*)(wa + (p * 32 + lr) * 72 + lc) = RA[p]; _Pragma("unroll") for (int p = 0; p < NBL; ++p) *(u32x4*)(wb + (p * 32 + lr) * 72 + lc) = RB[p]; }
#define G_COMPUTE(BUF) { __builtin_amdgcn_s_setprio(1); const bf16_t* ca = sa + (BUF) * 128 * 72 + (wr * 64 + r32) * 72 + hh * 8; const bf16_t* cb = sb + (BUF) * BROWS * 72 + (wc * 32 * NTW + r32) * 72 + hh * 8; \
        _Pragma("unroll") for (int ks = 0; ks < 4; ++ks) { const bf16x8 a0 = *(const bf16x8*)(ca + ks * 16), a1 = *(const bf16x8*)(ca + 32 * 72 + ks * 16); \
            _Pragma("unroll") for (int nt = 0; nt < NTW; ++nt) { const bf16x8 b0 = *(const bf16x8*)(cb + nt * 32 * 72 + ks * 16); acc[0][nt] = MFMA32(a0, b0, acc[0][nt]); acc[1][nt] = MFMA32(a1, b0, acc[1][nt]); } }  __builtin_amdgcn_s_setprio(0); }
    G_LOAD(ra0, rb0, 0);
    G_LOAD(ra1, rb1, 1);
    G_STORE(ra0, rb0, 0);
    __syncthreads();
    for (int kt = 0; kt < nk; kt += 2) {
        if (kt + 2 < nk) G_LOAD(ra0, rb0, kt + 2);
        __builtin_amdgcn_sched_barrier(0);
        G_COMPUTE(0);
        hook(kt, acc);
        G_STORE(ra1, rb1, 1);
        __syncthreads();
        if (kt + 3 < nk) G_LOAD(ra1, rb1, kt + 3);
        __builtin_amdgcn_sched_barrier(0);
        G_COMPUTE(1);
        hook(kt + 1, acc);
        if (kt + 2 < nk) G_STORE(ra0, rb0, 0);
        __syncthreads();
    }
#undef G_LOAD
#undef G_STORE
#undef G_COMPUTE
}

template <int NTW, class AR, class HK>
DI void gemm_main1(const bf16_t* __restrict__ A, int lda, AR arow, const bf16_t* __restrict__ Bt, int ldb, int col0, int nk,
                  f32x16 (&acc)[2][NTW], unsigned char* smraw, HK hook, int tid) {
    constexpr int BROWS = 64 * NTW, NBL = 2 * NTW;
    bf16_t* sa = (bf16_t*)smraw;
    bf16_t* sb = sa + 2 * 128 * 72;
    const int lane = tid & 63, wave = __builtin_amdgcn_readfirstlane(tid >> 6), wr = wave >> 1, wc = wave & 1, r32 = lane & 31, hh = lane >> 5;
    const int lr = tid >> 3, lc = (tid & 7) * 8;
    const bf16_t* ap[4];
    const bf16_t* bp[NBL];
#pragma unroll
    for (int p = 0; p < 4; ++p) ap[p] = A + (size_t)arow(p * 32 + lr) * lda + lc;
#pragma unroll
    for (int p = 0; p < NBL; ++p) bp[p] = Bt + (size_t)(col0 + p * 32 + lr) * ldb + lc;
    u32x4 ra[4], rb[NBL];
#pragma unroll
    for (int p = 0; p < 4; ++p) ra[p] = *(const u32x4*)(ap[p]);
#pragma unroll
    for (int p = 0; p < NBL; ++p) rb[p] = *(const u32x4*)(bp[p]);
#pragma unroll
    for (int p = 0; p < 4; ++p) *(u32x4*)(sa + (p * 32 + lr) * 72 + lc) = ra[p];
#pragma unroll
    for (int p = 0; p < NBL; ++p) *(u32x4*)(sb + (p * 32 + lr) * 72 + lc) = rb[p];
    __syncthreads();
    for (int kt = 0; kt < nk; ++kt) {
        const int buf = kt & 1;
        if (kt + 1 < nk) {
#pragma unroll
            for (int p = 0; p < 4; ++p) ra[p] = *(const u32x4*)(ap[p] + (kt + 1) * 64);
#pragma unroll
            for (int p = 0; p < NBL; ++p) rb[p] = *(const u32x4*)(bp[p] + (kt + 1) * 64);
        }
        __builtin_amdgcn_sched_barrier(0);
        const bf16_t* ca = sa + buf * 128 * 72 + (wr * 64 + r32) * 72 + hh * 8;
        const bf16_t* cb = sb + buf * BROWS * 72 + (wc * 32 * NTW + r32) * 72 + hh * 8;
#pragma unroll
        for (int ks = 0; ks < 4; ++ks) {
            const bf16x8 a0 = *(const bf16x8*)(ca + ks * 16), a1 = *(const bf16x8*)(ca + 32 * 72 + ks * 16);
#pragma unroll
            for (int nt = 0; nt < NTW; ++nt) {
                const bf16x8 b0 = *(const bf16x8*)(cb + nt * 32 * 72 + ks * 16);
                acc[0][nt] = MFMA32(a0, b0, acc[0][nt]);
                acc[1][nt] = MFMA32(a1, b0, acc[1][nt]);
            }
        }
        hook(kt, acc);
        if (kt + 1 < nk) {
            bf16_t* wa = sa + (buf ^ 1) * 128 * 72;
            bf16_t* wb = sb + (buf ^ 1) * BROWS * 72;
#pragma unroll
            for (int p = 0; p < 4; ++p) *(u32x4*)(wa + (p * 32 + lr) * 72 + lc) = ra[p];
#pragma unroll
            for (int p = 0; p < NBL; ++p) *(u32x4*)(wb + (p * 32 + lr) * 72 + lc) = rb[p];
        }
        __syncthreads();
    }
}

struct RowPlain { int r0; DI int operator()(int r) const { return r0 + r; } };
struct RowClamp { int base, t0; DI int operator()(int r) const { int t = t0 + r; t = t < 0 ? 0 : (t > S - 1 ? S - 1 : t); return base + t; } };

DI void zero_acc(f32x16 (&acc)[2][2]) {
#pragma unroll
    for (int a = 0; a < 2; ++a)
#pragma unroll
        for (int b = 0; b < 2; ++b)
#pragma unroll
            for (int i = 0; i < 16; ++i) acc[a][b][i] = 0.f;
}

DI void attn_pass(const bf16_t* __restrict__ Qp, int qs, const bf16_t* __restrict__ Kp, int ksr, const bf16_t* __restrict__ Vt,
                  const float* __restrict__ cum, const unsigned* __restrict__ selm, float scale, int nks, int mode, int q0,
                  f32x16 (&O)[2], unsigned char* smraw, int wave, int lane, int tid) {
    constexpr int KROW = 104, KT = 64 * KROW, VT = 64 * 68;
    bf16_t* sK = (bf16_t*)smraw;
    bf16_t* sV = sK + 2 * KT;
    float* sC = (float*)(smraw + 2 * KT * 2 + 2 * VT * 2);
    const int r32 = lane & 31, hh = lane >> 5;
    const int qw = q0 + wave * 32, t = qw + r32;
    bf16x8* sQ = (bf16x8*)(smraw + 2 * KT * 2 + 2 * VT * 2 + 512) + wave * 6 * 64 + lane;
#pragma unroll
    for (int ks = 0; ks < 6; ++ks) if (ks < nks) sQ[ks * 64] = *(const bf16x8*)(Qp + (size_t)t * qs + ks * 16 + hh * 8);
    float cq = 0.f; unsigned smk = 0xffffffffu;
    if (mode == 1) cq = cum[t];
    if (mode == 2) smk = selm[t];
    const int win = (mode == 3) ? 512 : (1 << 30);
    const float c2 = scale * 1.4426950408889634f, ic2 = 1.f / scale;
    int kt0 = 0; const int kt1 = q0 / 64 + 2;
    if (mode == 3) { kt0 = q0 / 64 - 8; if (kt0 < 0) kt0 = 0; }
#pragma unroll
    for (int i = 0; i < 16; ++i) { O[0][i] = 0.f; O[1][i] = 0.f; }
    float m = -1e30f, l = 0.f;
    const int nkc = nks >> 1, cpr = nks * 2;
    int krc[3];
#pragma unroll
    for (int p = 0; p < 3; ++p) { const int c = p * 256 + tid, row = c / cpr, cc = c - row * cpr; krc[p] = row | (cc << 8); }
#define KG(p) ((krc[p] & 255) * ksr + (krc[p] >> 8) * 8)
#define KL(p) ((krc[p] & 255) * KROW + (krc[p] >> 8) * 8)
#define VG(p) ((((p) * 256 + tid) >> 3) * S + (((p) * 256 + tid) & 7) * 8)
#define VL(p) ((((p) * 256 + tid) >> 3) * 68 + (((p) * 256 + tid) & 7) * 8)
    u32x4 rk[3], rv[2]; float rc = 0.f;
    {
        const bf16_t* kp = Kp + (size_t)kt0 * 64 * ksr; const bf16_t* vp = Vt + kt0 * 64;
#pragma unroll
        for (int p = 0; p < 3; ++p) if (p < nkc) rk[p] = *(const u32x4*)(kp + KG(p));
#pragma unroll
        for (int p = 0; p < 2; ++p) rv[p] = *(const u32x4*)(vp + VG(p));
        if (mode == 1 && tid < 64) rc = cum[kt0 * 64 + tid];
#pragma unroll
        for (int p = 0; p < 3; ++p) if (p < nkc) *(u32x4*)(sK + KL(p)) = rk[p];
#pragma unroll
        for (int p = 0; p < 2; ++p) { u32x2* d = (u32x2*)(sV + VL(p)); d[0] = (u32x2){rv[p][0], rv[p][1]}; d[1] = (u32x2){rv[p][2], rv[p][3]}; }
        if (mode == 1 && tid < 64) sC[tid] = rc;
    }
    __syncthreads();
    for (int kt = kt0; kt < kt1; ++kt) {
        const int buf = (kt - kt0) & 1;
        if (kt + 1 < kt1) {
            const bf16_t* kp = Kp + (size_t)(kt + 1) * 64 * ksr; const bf16_t* vp = Vt + (kt + 1) * 64;
#pragma unroll
            for (int p = 0; p < 3; ++p) if (p < nkc) rk[p] = *(const u32x4*)(kp + KG(p));
#pragma unroll
            for (int p = 0; p < 2; ++p) rv[p] = *(const u32x4*)(vp + VG(p));
            if (mode == 1 && tid < 64) rc = cum[(kt + 1) * 64 + tid];
        }
        bool act = (kt * 64 <= qw + 31) && (kt * 64 + 63 > qw - win);
        const bool selb = ((smk >> kt) & 1u) != 0u;
        const unsigned long long selbal = __ballot(selb);
        act = act && (selbal != 0ull);
        if (act) {
            const bool full = (kt * 64 + 63 <= qw) && (kt * 64 > qw + 31 - win) && (selbal == ~0ull);
#pragma nounroll
            for (int kb = 0; kb < 2; ++kb) {
                f32x16 Sx;
#pragma unroll
                for (int i = 0; i < 16; ++i) Sx[i] = 0.f;
                const bf16_t* kr = sK + buf * KT + (kb * 32 + r32) * KROW + hh * 8;
#pragma unroll
                for (int ks = 0; ks < 6; ++ks) if (ks < nks) { const bf16x8 a = *(const bf16x8*)(kr + ks * 16); const bf16x8 qv = sQ[ks * 64]; Sx = MFMA32(a, qv, Sx); }
                if (mode == 1) {
#pragma unroll
                    for (int g = 0; g < 4; ++g) {
                        const f32x4 ck = *(const f32x4*)(sC + buf * 64 + kb * 32 + 8 * g + 4 * hh);
#pragma unroll
                        for (int e = 0; e < 4; ++e) Sx[4 * g + e] += (cq - ck[e]) * ic2;
                    }
                }
                if (!full) {
                    const int kbase = kt * 64 + kb * 32 + 4 * hh;
#pragma unroll
                    for (int i = 0; i < 16; ++i) {
                        const int key = kbase + (i & 3) + 8 * (i >> 2);
                        const bool ok = (key <= t) && (key > t - win) && selb;
                        Sx[i] = ok ? Sx[i] : -3e38f;
                    }
                }
                float mx = -3e38f;
#pragma unroll
                for (int i = 0; i < 16; ++i) mx = fmaxf(mx, Sx[i]);
                mx = fmaxf(mx, __shfl_xor(mx, 32));
                mx = fmaxf(mx * c2, -1e30f);
                if (__ballot(mx - m > 6.0f) != 0ull) {
                    const float mn = fmaxf(m, mx), alpha = __builtin_amdgcn_exp2f(m - mn);
                    m = mn;
#pragma unroll
                    for (int i = 0; i < 16; ++i) { O[0][i] *= alpha; O[1][i] *= alpha; }
                    l *= alpha;
                }
                const float mneg = -m;
                float rs = 0.f;
#pragma unroll
                for (int i = 0; i < 16; ++i) { const float pp = __builtin_amdgcn_exp2f(fmaf(Sx[i], c2, mneg)); Sx[i] = pp; rs += pp; }
                l += rs;
#pragma unroll
                for (int s2 = 0; s2 < 2; ++s2) {
                    u32x4 pw;
                    pw[0] = pk2(Sx[8 * s2 + 0], Sx[8 * s2 + 1]); pw[1] = pk2(Sx[8 * s2 + 2], Sx[8 * s2 + 3]);
                    pw[2] = pk2(Sx[8 * s2 + 4], Sx[8 * s2 + 5]); pw[3] = pk2(Sx[8 * s2 + 6], Sx[8 * s2 + 7]);
                    const bf16x8 pb = __builtin_bit_cast(bf16x8, pw);
#pragma unroll
                    for (int dvb = 0; dvb < 2; ++dvb) {
                        const bf16_t* vr = sV + buf * VT + (dvb * 32 + r32) * 68 + kb * 32 + 16 * s2 + 4 * hh;
                        const s16x4 lo = *(const s16x4*)vr, hi = *(const s16x4*)(vr + 8);
                        const bf16x8 va = __builtin_shufflevector(lo, hi, 0, 1, 2, 3, 4, 5, 6, 7);
                        O[dvb] = MFMA32(va, pb, O[dvb]);
                    }
                }
            }
        }
        if (kt + 1 < kt1) {
            const int nb = buf ^ 1;
#pragma unroll
            for (int p = 0; p < 3; ++p) if (p < nkc) *(u32x4*)(sK + nb * KT + KL(p)) = rk[p];
#pragma unroll
            for (int p = 0; p < 2; ++p) { u32x2* d = (u32x2*)(sV + nb * VT + VL(p)); d[0] = (u32x2){rv[p][0], rv[p][1]}; d[1] = (u32x2){rv[p][2], rv[p][3]}; }
            if (mode == 1 && tid < 64) sC[nb * 64 + tid] = rc;
        }
        __syncthreads();
    }
    l += __shfl_xor(l, 32);
    const float inv = 1.f / l;
#pragma unroll
    for (int i = 0; i < 16; ++i) { O[0][i] *= inv; O[1][i] *= inv; }
}

DI void store_o(bf16_t* dst, const f32x16 (&O)[2], int hh) {
#pragma unroll
    for (int dvb = 0; dvb < 2; ++dvb)
#pragma unroll
        for (int g = 0; g < 4; ++g) {
            u32x2 w = {pk2(O[dvb][4 * g], O[dvb][4 * g + 1]), pk2(O[dvb][4 * g + 2], O[dvb][4 * g + 3])};
            *(u32x2*)(dst + dvb * 32 + 8 * g + 4 * hh) = w;
        }
}

template <int GW>
DI float norm_rope(float v, const float* __restrict__ gain, const f32x2* __restrict__ rope_tok, int nrot, int ra, int lane) {
    float ss = v * v;
    ss = (GW == 64) ? wsum(ss) : sum32(ss);
    const int j = lane & (GW - 1);
    float y = v * rsqrtf(ss * (1.f / GW) + EPS) * gain[j];
    if (nrot) {
        const int half = nrot >> 1;
        const float partner = __shfl_xor(y, half);
        if (j < nrot) {
            const f32x2 cs = rope_tok[ra + (j & (half - 1))];
            y = (j < half) ? (y * cs[0] - partner * cs[1]) : (y * cs[0] + partner * cs[1]);
        }
    }
    return y;
}

DI bool xcd_unit(int k, int R, int ntn, int& tmg, int& tn) {
    const int x = blockIdx.x & 7, j = (int)(blockIdx.x >> 3) + k * (int)(gridDim.x >> 3);
    if (j >= R * ntn) return false;
    const int g0 = (R + 1) >> 1;
    int w = j, r0 = 0, gs = g0;
    if (j >= g0 * ntn) { w = j - g0 * ntn; r0 = g0; gs = R - g0; }
    tn = w / gs; tmg = x * R + r0 + (w - tn * gs);
    return true;
}

DI unsigned xb_ld(unsigned* p) { return __hip_atomic_load(p, __ATOMIC_RELAXED, __HIP_MEMORY_SCOPE_AGENT); }
DI unsigned xb_add(unsigned* p, unsigned v) { return __hip_atomic_fetch_add(p, v, __ATOMIC_RELAXED, __HIP_MEMORY_SCOPE_AGENT); }
DI unsigned xcc_id() { return (unsigned)__builtin_amdgcn_s_getreg((3 << 11) | 20) & 0xFu; }
DI void xbar(unsigned* bar, unsigned x, unsigned nloc, unsigned nx, int tid) {
    asm volatile("s_waitcnt vmcnt(0)" ::: "memory");
    __syncthreads();
    if (tid == 0) {
        __builtin_amdgcn_s_waitcnt(0);
        const unsigned old = xb_add(&bar[1024 + 64 * x], 1u);
        const unsigned gen = old / nloc;
        if (old + 1u == (gen + 1u) * nloc) {
            __builtin_amdgcn_fence(__ATOMIC_RELEASE, "agent");
            asm volatile("s_waitcnt vmcnt(0)" ::: "memory");
            const unsigned og = xb_add(&bar[3072], 1u);
            const unsigned tg = og / nx;
            if (og + 1u == (tg + 1u) * nx) xb_add(&bar[3136], 1u);
            else while (xb_ld(&bar[3136]) == tg) __builtin_amdgcn_s_sleep(1);
            __builtin_amdgcn_fence(__ATOMIC_ACQUIRE, "agent");
            xb_add(&bar[2048 + 64 * x], 1u);
            asm volatile("s_waitcnt vmcnt(0)" ::: "memory");
        } else {
            while (xb_ld(&bar[2048 + 64 * x]) == gen) __builtin_amdgcn_s_sleep(1);
            __builtin_amdgcn_fence(__ATOMIC_ACQUIRE, "agent");
            asm volatile("s_waitcnt vmcnt(0)" ::: "memory");
        }
    }
    __syncthreads();
}

__global__ void __launch_bounds__(NT, 2) mega(Params p) {
    extern __shared__ __attribute__((aligned(16))) unsigned char smem[];
    cg::grid_group grid = cg::this_grid();
    bool probe_second = false;
    int nbar = 0;
    unsigned* xbw = (unsigned*)(p.ws + WS_BAR);
    const unsigned xcc = (unsigned)__builtin_amdgcn_readfirstlane((int)xcc_id());
    unsigned xb_nloc = 1u, xb_nx = 1u;
    if (threadIdx.x == 0) xb_add(&xbw[64 * xcc], 1u);
    const int wave_s = __builtin_amdgcn_readfirstlane((int)(threadIdx.x >> 6));
    for (int ph = p.ph_lo; ph < p.ph_hi; ++ph) {
        int zop = 0; asm volatile("" : "+s"(zop));
        const int tid = wave_s * 64 + (int)__builtin_amdgcn_mbcnt_hi(~0u, __builtin_amdgcn_mbcnt_lo(~0u, (unsigned)zop));
        if (ph > p.ph_lo || probe_second) {
            if (nbar == 0) {
                grid.sync();
                unsigned cnt = 0u, mine = 1u;
                for (unsigned j = 0; j < 16; ++j) { const unsigned c = xb_ld(&xbw[64 * j]); cnt += (c > 0u) ? 1u : 0u; if (j == xcc) mine = c; }
                xb_nloc = (unsigned)__builtin_amdgcn_readfirstlane((int)(mine > 0u ? mine : 1u));
                xb_nx = (unsigned)__builtin_amdgcn_readfirstlane((int)(cnt > 0u ? cnt : 1u));
            } else xbar(xbw, xcc, xb_nloc, xb_nx, tid);
            ++nbar;
        }
        const int lane = tid & 63, wave = __builtin_amdgcn_readfirstlane(tid >> 6), r32 = lane & 31, hh = lane >> 5;
        const int wr = wave >> 1, wc = wave & 1;
        unsigned char* ws = p.ws;
        unsigned* ctr = (unsigned*)(ws + WS_CTR);
        float* modb = (float*)(ws + WS_MOD);
        f32x2* rope = (f32x2*)(ws + WS_ROPE);
        bf16_t* Wb = (bf16_t*)(ws + WS_W);
        bf16_t* w_in_t = (bf16_t*)(ws + WS_W + W_IN);
        bf16_t* w_g_t = (bf16_t*)(ws + WS_W + W_G);
        bf16_t* w_br_t = (bf16_t*)(ws + WS_W + W_BR);
        bf16_t* w_o_t = (bf16_t*)(ws + WS_W + W_O);
        bf16_t* w_up_t = (bf16_t*)(ws + WS_W + W_UP);
        bf16_t* w_dn_t = (bf16_t*)(ws + WS_W + W_DN);
        bf16_t* w_uq_t = (bf16_t*)(ws + WS_W + W_UQ);
        bf16_t* w_ukv_t = (bf16_t*)(ws + WS_W + W_UKV);
        (void)Wb;
        bf16_t* hbuf = (bf16_t*)(ws + WS_H);
        float* parts = (float*)(ws + WS_R1);
        bf16_t* gates = (bf16_t*)(ws + WS_R1 + R1_GATES);
        bf16_t* obuf = (bf16_t*)(ws + WS_R1 + R1_OBUF);
        bf16_t* abuf = (bf16_t*)(ws + WS_R1 + R1_ABUF);
        unsigned char* r2 = ws + WS_R2;
        bf16_t* qnsa = (bf16_t*)(r2 + R2_QNSA);
        float* qfnsa = (float*)(r2 + R2_QFNSA);
        bf16_t* ksb = (bf16_t*)(r2 + R2_KS);
        bf16_t* kwb = (bf16_t*)(r2 + R2_KW);
        bf16_t* vts = (bf16_t*)(r2 + R2_VTS);
        bf16_t* vtw = (bf16_t*)(r2 + R2_VTW);
        float* gn = (float*)(r2 + R2_GN);
        float* kcmp = (float*)(r2 + R2_KCMP);
        float* vcmp = (float*)(r2 + R2_VCMP);
        float* ocmp = (float*)(r2 + R2_OCMP);
        unsigned* selm = (unsigned*)(r2 + R2_SELM);
        bf16_t* fq = (bf16_t*)(r2 + R2_FQ);
        bf16_t* fk = (bf16_t*)(r2 + R2_FK);
        bf16_t* fvt = (bf16_t*)(r2 + R2_FVT);
        float* cumb = (float*)(r2 + R2_CUM);
        bf16_t* mq = (bf16_t*)(r2 + R2_MQ);
        bf16_t* mk = (bf16_t*)(r2 + R2_MK);
        bf16_t* mvt = (bf16_t*)(r2 + R2_MVT);
        bf16_t* dq = (bf16_t*)(r2 + R2_DQ);
        bf16_t* dkb = (bf16_t*)(r2 + R2_DK);
        bf16_t* dvt = (bf16_t*)(r2 + R2_DVT);
        float* dtmp = (float*)(r2 + R2_DTMP);
        float* ntmp = (float*)(r2 + R2_NTMP);

        const float* x_in = p.in[0];
        const float* c_in = p.in[1];
        const int* pos_in = (const int*)p.in[2];
        float* xo = p.out;

        if (ph == 0) {
            if (!EN(0)) continue;
            if (blockIdx.x == 0 && tid < 16) ctr[tid] = 0u;
            for (int idx = blockIdx.x * NT + tid; idx < M * 28; idx += gridDim.x * NT) {
                const int tok = idx / 28, a = idx % 28;
                float e;
                if (a < 8) e = -(float)a / 8.f; else if (a < 24) e = -(float)(a - 8) / 16.f; else e = -(float)(a - 24) / 4.f;
                const float inv_freq = powf(500000.f, e);
                const float ang = (float)pos_in[tok] * inv_freq;
                rope[idx] = (f32x2){cosf(ang), sinf(ang)};
            }
            float* sc = (float*)smem;
            float* red = sc + 8 * 1024;
            for (int i = tid; i < 8192; i += NT) sc[i] = siluf_(c_in[i]);
            __syncthreads();
            for (int job = blockIdx.x; job < NL * 96; job += gridDim.x) {
                const int l = job / 96, cgp = job % 96;
                const int kq = tid >> 6, j = tid & 63, col = cgp * 64 + j;
                float acc[8];
#pragma unroll
                for (int b = 0; b < 8; ++b) acc[b] = 0.f;
                const float* wp = p.in[3] + ((size_t)l * 1024 + kq * 256) * 6144 + col;
                for (int k = 0; k < 256; ++k) {
                    const float w = wp[(size_t)k * 6144];
#pragma unroll
                    for (int b = 0; b < 8; ++b) acc[b] += sc[b * 1024 + kq * 256 + k] * w;
                }
#pragma unroll
                for (int b = 0; b < 8; ++b) red[(kq * 8 + b) * 64 + j] = acc[b];
                __syncthreads();
                if (kq == 0) {
#pragma unroll
                    for (int b = 0; b < 8; ++b) {
                        const float v = red[(0 * 8 + b) * 64 + j] + red[(1 * 8 + b) * 64 + j] + red[(2 * 8 + b) * 64 + j] + red[(3 * 8 + b) * 64 + j];
                        modb[((size_t)l * 8 + b) * 6144 + col] = v + p.in[4][l * 6144 + col];
                    }
                }
                __syncthreads();
            }
            if (PROBE_SUB == 100 && !probe_second) { probe_second = true; --ph; } else probe_second = false;
            continue;
        }
        const int l = (ph - 1) / 10, sub = (ph - 1) % 10;
        const float* xcur = (l == 0) ? x_in : xo;
        const float* modl = modb + (size_t)l * 8 * 6144;
        if ((sub == 0 || sub == 7) && EN(1)) {
            if (sub == 0) {
                float* tsm = (float*)smem;
                tc_matrix(p.in[5] + (size_t)l * 1024 * NIN, 1024, NIN, w_in_t, 1024, tsm, 0, tid);
                for (int i = blockIdx.x * NT + tid; i < 64 * 1024 / 8; i += gridDim.x * NT) ((u32x4*)(w_in_t + (size_t)2624 * 1024))[i] = (u32x4){0u, 0u, 0u, 0u};
                tc_matrix(p.in[21] + (size_t)l * 1024 * 4096, 1024, 4096, w_g_t, 1024, tsm, 0, tid);
                tc_matrix(p.in[20] + (size_t)l * 1024 * 1024, 1024, 1024, w_br_t, 1024, tsm, 0, tid);
                tc_matrix(p.in[23] + (size_t)l * 1024 * 1024, 1024, 1024, w_o_t, 1024, tsm, 0, tid);
                tc_matrix(p.in[24] + (size_t)l * 1024 * 5632, 1024, 5632, w_up_t, 1024, tsm, 1, tid);
                tc_matrix(p.in[27] + (size_t)l * DFF * 1024, DFF, 1024, w_dn_t, DFF, tsm, 0, tid);
                tc_matrix(p.in[14] + (size_t)l * 256 * 384, 256, 384, w_uq_t, 256, tsm, 0, tid);
                tc_matrix(p.in[15] + (size_t)l * 128 * 512, 128, 512, w_ukv_t, 128, tsm, 0, tid);
            }
            const float* xs = (sub == 0) ? xcur : xo;
            const int osh = (sub == 0) ? 0 : 3072, osc = osh + 1024;
            for (int tok = blockIdx.x * 4 + wave; tok < M; tok += gridDim.x * 4) {
                const int b = tok / S;
                const f32x4* xr = (const f32x4*)(xs + (size_t)tok * D);
                f32x4 v[4]; float ss = 0.f;
#pragma unroll
                for (int i = 0; i < 4; ++i) { v[i] = xr[lane + 64 * i]; ss += v[i][0] * v[i][0] + v[i][1] * v[i][1] + v[i][2] * v[i][2] + v[i][3] * v[i][3]; }
                ss = wsum(ss);
                const float rstd = rsqrtf(ss * (1.f / D) + EPS);
                const float* mb = modl + (size_t)b * 6144;
#pragma unroll
                for (int i = 0; i < 4; ++i) {
                    const int col = (lane + 64 * i) * 4;
                    const f32x4 scv = *(const f32x4*)(mb + osc + col), shv = *(const f32x4*)(mb + osh + col);
                    float o[4];
#pragma unroll
                    for (int e = 0; e < 4; ++e) o[e] = v[i][e] * rstd * (1.f + scv[e]) + shv[e];
                    *(u32x2*)(hbuf + (size_t)tok * D + col) = (u32x2){pk2(o[0], o[1]), pk2(o[2], o[3])};
                }
            }
        } else if (sub == 1 && EN(2)) {
            const int ntn = NINP / 128;
            for (int k = 0;; ++k) {
                int tm, tn; if (!xcd_unit(k, 16, ntn, tm, tn)) break;
                f32x16 acc[2][2]; zero_acc(acc);
                gemm_main<2>(hbuf, D, RowPlain{tm * 128}, w_in_t, D, tn * 128, D / 64, acc, smem, NoHook{}, tid);
#pragma unroll
                for (int mt = 0; mt < 2; ++mt)
#pragma unroll
                    for (int nt = 0; nt < 2; ++nt)
#pragma unroll
                        for (int i = 0; i < 16; ++i) {
                            const int row = tm * 128 + wr * 64 + mt * 32 + crow(i, hh), col = tn * 128 + wc * 64 + nt * 32 + r32;
                            parts[(size_t)row * NINP + col] = acc[mt][nt][i];
                        }
            }
        } else if (sub == 2 && EN(3)) {
            const int NJ_MLA = 2 * (M / 64), NJ_CMP = NB * 2 * 32, NJ_TC = 10 * (M / 256), NJ_TOK = M / 32, NJ_CUM = 8;
            const int NJ = NJ_MLA + NJ_CMP + NJ_TC + NJ_TOK + NJ_CUM;
            unsigned* sj = (unsigned*)(smem + LDS_BYTES - 16);
            for (;;) {
                __syncthreads();
                if (tid == 0) *sj = atomicAdd(&ctr[16 + l + (probe_second ? 4 : 0)], 1u);
                __syncthreads();
                const int job = __builtin_amdgcn_readfirstlane((int)*sj);
                if (job >= NJ) break;
                int jj = job;
                if (jj < NJ_CUM) {
                {
                    const int bh = jj * 4 + wave, b = bh >> 2, hd = bh & 3;
                    const float fb = p.in[11][l * 4 + hd];
                    float vals[32]; float run = 0.f;
#pragma unroll
                    for (int i = 0; i < 32; ++i) {
                        const int t = lane * 32 + i;
                        const float xv = parts[(size_t)(b * S + t) * NINP + 1420 + hd] + fb;
                        const float ls = fminf(xv, 0.f) - log1pf(__expf(-fabsf(xv)));
                        run += ls; vals[i] = run;
                    }
                    float incl = run;
#pragma unroll
                    for (int o = 1; o < 64; o <<= 1) { const float v = __shfl_up(incl, o); if (lane >= o) incl += v; }
                    const float off = incl - run;
#pragma unroll
                    for (int i = 0; i < 32; ++i) cumb[(size_t)bh * S + lane * 32 + i] = off + vals[i];
                }
                    continue;
                }
                jj -= NJ_CUM;
                if (jj < NJ_MLA + NJ_CMP) {
                    const int seg = jj >> 8, off = jj & 255;
                    jj = (seg & 1) ? NJ_MLA + (seg >> 1) * 256 + off : (seg >> 1) * 256 + off;
                }
                if (jj < NJ_MLA) {
                    const bool doq = jj < (M / 64);
                    const int tok0 = (jj & (M / 64 - 1)) * 64, b = tok0 / S, t0 = tok0 % S;
                    bf16_t* aq = (bf16_t*)smem;
                    bf16_t* akv = aq + 64 * 264;
                    float* kr = (float*)(akv + 64 * 136);
                    float* krss = kr + 64 * 32;
                    float* rkk = krss + 64;
                    if (doq) {
                        const f32x4 g = *(const f32x4*)(p.in[12] + l * 256 + lane * 4);
#pragma unroll 1
                        for (int rb = wave * 16; rb < wave * 16 + 16; rb += 8) {
                            f32x4 v[8];
#pragma unroll
                            for (int k = 0; k < 8; ++k) v[k] = *(const f32x4*)(parts + (size_t)(tok0 + rb + k) * NINP + 1424 + lane * 4);
#pragma unroll
                            for (int k = 0; k < 8; ++k) {
                                const float ss = wsum(v[k][0] * v[k][0] + v[k][1] * v[k][1] + v[k][2] * v[k][2] + v[k][3] * v[k][3]);
                                const float rstd = rsqrtf(ss * (1.f / 256.f) + EPS);
                                *(u32x2*)(aq + (rb + k) * 264 + lane * 4) = (u32x2){pk2(v[k][0] * rstd * g[0], v[k][1] * rstd * g[1]), pk2(v[k][2] * rstd * g[2], v[k][3] * rstd * g[3])};
                            }
                        }
                    } else {
                        const f32x2 g2 = *(const f32x2*)(p.in[13] + l * 128 + lane * 2);
#pragma unroll 1
                        for (int rb = wave * 16; rb < wave * 16 + 16; rb += 8) {
                            f32x2 w[8]; float kvv[8];
#pragma unroll
                            for (int k = 0; k < 8; ++k) {
                                const float* pr = parts + (size_t)(tok0 + rb + k) * NINP;
                                w[k] = *(const f32x2*)(pr + 1680 + lane * 2);
                                kvv[k] = (lane < 32) ? pr[1808 + lane] : 0.f;
                            }
#pragma unroll
                            for (int k = 0; k < 8; ++k) {
                                const int r = rb + k;
                                const float ss = wsum(w[k][0] * w[k][0] + w[k][1] * w[k][1]);
                                const float rstd = rsqrtf(ss * (1.f / 128.f) + EPS);
                                *(unsigned*)(akv + r * 136 + lane * 2) = pk2(w[k][0] * rstd * g2[0], w[k][1] * rstd * g2[1]);
                                if (lane < 32) kr[r * 32 + lane] = kvv[k];
                                const float s2 = wsum(kvv[k] * kvv[k]);
                                if (lane == 0) krss[r] = s2;
                            }
                        }
                    }
                    __syncthreads();
                    const float* gq = p.in[16] + (size_t)l * 192;
                    const float* gk = gq + 96;
                    if (doq) {
#pragma unroll 1
                        for (int mt = 0; mt < 2; ++mt) {
                            f32x16 acc[3];
#pragma unroll
                            for (int c = 0; c < 3; ++c)
#pragma unroll
                                for (int i = 0; i < 16; ++i) acc[c][i] = 0.f;
#pragma unroll 8
                            for (int ks = 0; ks < 16; ++ks) {
                                const bf16x8 a0 = *(const bf16x8*)(aq + (mt * 32 + r32) * 264 + ks * 16 + hh * 8);
#pragma unroll
                                for (int nt = 0; nt < 3; ++nt) {
                                    const bf16x8 bb = *(const bf16x8*)(w_uq_t + (size_t)(wave * 96 + nt * 32 + r32) * 256 + ks * 16 + hh * 8);
                                    acc[nt] = MFMA32(a0, bb, acc[nt]);
                                }
                            }
                            const float gq0 = gq[r32], gq1 = gq[32 + r32], gq2 = gq[64 + r32];
#pragma unroll
                            for (int i = 0; i < 16; ++i) {
                                float ss = acc[0][i] * acc[0][i] + acc[1][i] * acc[1][i] + acc[2][i] * acc[2][i];
                                ss = sum32(ss);
                                const float rstd = rsqrtf(ss * (1.f / 96.f) + EPS);
                                const int row = mt * 32 + crow(i, hh), tok = tok0 + row;
                                float y0 = acc[0][i] * rstd * gq0;
                                const float y1 = acc[1][i] * rstd * gq1, y2 = acc[2][i] * rstd * gq2;
                                const float partner = __shfl_xor(y0, 16);
                                const f32x2 cs = rope[(size_t)tok * 28 + 8 + (r32 & 15)];
                                y0 = (r32 < 16) ? (y0 * cs[0] - partner * cs[1]) : (y0 * cs[0] + partner * cs[1]);
                                bf16_t* d = mq + (size_t)tok * 384 + wave * 96 + r32;
                                d[0] = f2bf(y0); d[32] = f2bf(y1); d[64] = f2bf(y2);
                                if ((i & 3) == 3) __builtin_amdgcn_sched_barrier(0);
                            }
                        }
                    }
                    if (!doq) {
#pragma unroll 1
                        for (int mt = 0; mt < 2; ++mt) {
                            f32x16 acc[4];
#pragma unroll
                            for (int c = 0; c < 4; ++c)
#pragma unroll
                                for (int i = 0; i < 16; ++i) acc[c][i] = 0.f;
#pragma unroll 8
                            for (int ks = 0; ks < 8; ++ks) {
                                const bf16x8 a0 = *(const bf16x8*)(akv + (mt * 32 + r32) * 136 + ks * 16 + hh * 8);
#pragma unroll
                                for (int nt = 0; nt < 4; ++nt) {
                                    const bf16x8 bb = *(const bf16x8*)(w_ukv_t + (size_t)(wave * 128 + nt * 32 + r32) * 128 + ks * 16 + hh * 8);
                                    acc[nt] = MFMA32(a0, bb, acc[nt]);
                                }
                            }
#pragma unroll
                            for (int i = 0; i < 16; ++i) {
                                const int row = mt * 32 + crow(i, hh), tok = tok0 + row;
                                float ss = acc[0][i] * acc[0][i] + acc[1][i] * acc[1][i];
                                ss = sum32(ss) + krss[row];
                                const float rstd = rsqrtf(ss * (1.f / 96.f) + EPS);
                                if (r32 == 0) rkk[row * 4 + wave] = rstd;
                                bf16_t* d = mk + (size_t)tok * 384 + wave * 96 + 32 + r32;
                                d[0] = f2bf(acc[0][i] * rstd * gk[32 + r32]);
                                d[32] = f2bf(acc[1][i] * rstd * gk[64 + r32]);
                            }
#pragma unroll
                            for (int nt = 2; nt < 4; ++nt)
#pragma unroll
                                for (int g = 0; g < 4; ++g) {
                                    const int dv = (nt - 2) * 32 + r32, tt = t0 + mt * 32 + 8 * g + 4 * hh;
                                    u32x2 w = {pk2(acc[nt][4 * g], acc[nt][4 * g + 1]), pk2(acc[nt][4 * g + 2], acc[nt][4 * g + 3])};
                                    *(u32x2*)(mvt + ((size_t)(b * 4 + wave) * 64 + dv) * S + tt) = w;
                                }
                        }
                    }
                    __syncthreads();
                    if (!doq)
                    for (int it = tid; it < 64 * 4 * 16; it += NT) {
                        const int row = it >> 6, hd = (it >> 4) & 3, j = it & 15, tok = tok0 + row;
                        const float rstd = rkk[row * 4 + hd];
                        const float x1 = kr[row * 32 + j] * rstd * gk[j], x2 = kr[row * 32 + 16 + j] * rstd * gk[16 + j];
                        const f32x2 cs = rope[(size_t)tok * 28 + 8 + j];
                        bf16_t* d = mk + (size_t)tok * 384 + hd * 96;
                        d[j] = f2bf(x1 * cs[0] - x2 * cs[1]);
                        d[16 + j] = f2bf(x2 * cs[0] + x1 * cs[1]);
                    }
                    __syncthreads();
                    continue;
                }
                jj -= NJ_MLA;
                if (jj < NJ_CMP) {
                    const int b = jj / 64, which = (jj / 32) & 1, c0 = (jj & 31) * 4;
                    float* B4 = (float*)smem;
                    float* red = B4 + 4 * 2048;
                    float* hid = red + 4 * 4 * 64;
                    const int colb = which ? 320 : 256;
                    const float* pe = p.in[7] + ((size_t)l * 2 + which) * 2048;
                    const float* w1 = p.in[8] + ((size_t)l * 2 + which) * 2048 * 64;
                    const float* w2 = p.in[9] + ((size_t)l * 2 + which) * 64 * 64;
#pragma unroll 1
                    for (int i0 = 0; i0 < 4 * 2048; i0 += 8 * NT) {
                        float xv[8], pv[8];
#pragma unroll
                        for (int k = 0; k < 8; ++k) {
                            const int i = i0 + k * NT + tid, ci = i >> 11, ii = i & 2047, pos = ii >> 6, d = ii & 63, t = (c0 + ci) * 16 + pos;
                            xv[k] = (t < S) ? parts[(size_t)(b * S + t) * NINP + colb + d] : 0.f; pv[k] = pe[ii];
                        }
#pragma unroll
                        for (int k = 0; k < 8; ++k) B4[i0 + k * NT + tid] = xv[k] + pv[k];
                    }
                    __syncthreads();
                    {
                        float a0 = 0.f, a1 = 0.f, a2 = 0.f, a3 = 0.f;
                        const float* wp = w1 + (size_t)(wave * 512) * 64 + lane;
                        const float* bp = B4 + wave * 512;
#pragma unroll 8
                        for (int i4 = 0; i4 < 128; ++i4) {
                            const f32x4 x0 = *(const f32x4*)(bp + i4 * 4), x1 = *(const f32x4*)(bp + 2048 + i4 * 4);
                            const f32x4 x2 = *(const f32x4*)(bp + 4096 + i4 * 4), x3 = *(const f32x4*)(bp + 6144 + i4 * 4);
#pragma unroll
                            for (int e = 0; e < 4; ++e) {
                                const float wv = wp[(size_t)(i4 * 4 + e) * 64];
                                a0 = fmaf(x0[e], wv, a0); a1 = fmaf(x1[e], wv, a1); a2 = fmaf(x2[e], wv, a2); a3 = fmaf(x3[e], wv, a3);
                            }
                        }
                        red[(wave * 4 + 0) * 64 + lane] = a0; red[(wave * 4 + 1) * 64 + lane] = a1;
                        red[(wave * 4 + 2) * 64 + lane] = a2; red[(wave * 4 + 3) * 64 + lane] = a3;
                    }
                    __syncthreads();
                    {
                        const int ci = wave, j = lane, c = c0 + ci;
                        const float hsum = red[(0 * 4 + ci) * 64 + j] + red[(1 * 4 + ci) * 64 + j] + red[(2 * 4 + ci) * 64 + j] + red[(3 * 4 + ci) * 64 + j];
                        hid[ci * 64 + j] = siluf_(hsum);
                        __syncthreads();
                        float o = 0.f;
#pragma unroll 16
                        for (int i = 0; i < 64; ++i) o += hid[ci * 64 + i] * w2[i * 64 + j];
                        if (which == 0) {
                            const float ss = wsum(o * o);
                            o = o * rsqrtf(ss * (1.f / 64.f) + EPS) * p.in[6][(size_t)l * 256 + 64 + j];
                        }
                        if (c < 127) (which ? vcmp : kcmp)[((size_t)b * 128 + c) * 64 + j] = o;
                    }
                    __syncthreads();
                    continue;
                }
                jj -= NJ_CMP;
                if (jj < 1024) {
                    const int seg = jj >> 8, off = jj & 255;
                    jj = (seg & 1) ? NJ_TC + (seg >> 1) * 256 + off : (seg >> 1) * 256 + off;
                } else jj -= 512;
                if (jj < NJ_TC) {
                    const int ct = jj / (M / 256), tt4 = jj % (M / 256);
                    const int tok0 = tt4 * 256, b = tok0 / S, t0 = tok0 % S;
                    int col; bf16_t* dst;
                    if (ct == 0) { col = 448; dst = vts + (size_t)b * 64 * S; }
                    else if (ct == 1) { col = 576; dst = vtw + (size_t)b * 64 * S; }
                    else if (ct < 6) { col = 1164 + (ct - 2) * 64; dst = fvt + (size_t)(b * 4 + ct - 2) * 64 * S; }
                    else { col = 2352 + (ct - 6) * 64; dst = dvt + (size_t)(b * 4 + ct - 6) * 64 * S; }
#pragma unroll 1
                    for (int k4 = 0; k4 < 4; ++k4) tc_tile(parts + (size_t)b * S * NINP, NINP, NINP, t0 + k4 * 64, col, dst, S, 0, (float*)smem, tid);
                    continue;
                }
                jj -= NJ_TC;
                if (jj < NJ_TOK) {
#pragma unroll 1
                    for (int ti = 0; ti < 8; ++ti) {
                    const int tok = jj * 32 + wave * 8 + ti;
                    const float* pr = parts + (size_t)tok * NINP;
                    const f32x2* rt = rope + (size_t)tok * 28;
                    const float* ng = p.in[6] + (size_t)l * 256;
                    float vq[4], vfq[4], vfk[4], vdq[4], vdk[4];
#pragma unroll
                    for (int hd = 0; hd < 4; ++hd) {
                        vq[hd] = pr[hd * 64 + lane]; vfq[hd] = pr[652 + hd * 64 + lane]; vfk[hd] = pr[908 + hd * 64 + lane];
                        vdq[hd] = pr[1840 + hd * 64 + lane]; vdk[hd] = pr[2096 + hd * 64 + lane];
                    }
                    const float vks = pr[384 + lane], vkw = pr[512 + lane], vg = (lane < 12) ? pr[640 + lane] : 0.f;
#pragma unroll
                    for (int hd = 0; hd < 4; ++hd) {
                        const float y = norm_rope<64>(vq[hd], ng, rt, 16, 0, lane);
                        qnsa[(size_t)tok * 256 + hd * 64 + lane] = f2bf(y);
                        qfnsa[(size_t)tok * 256 + hd * 64 + lane] = y;
                    }
                    ksb[(size_t)tok * 64 + lane] = f2bf(norm_rope<64>(vks, ng + 128, rt, 16, 0, lane));
                    kwb[(size_t)tok * 64 + lane] = f2bf(norm_rope<64>(vkw, ng + 192, rt, 16, 0, lane));
                    if (lane < 12) gn[(size_t)tok * 12 + lane] = sigmoidf_(vg);
                    const float* fg = p.in[10] + (size_t)l * 128;
#pragma unroll
                    for (int hd = 0; hd < 4; ++hd) {
                        fq[(size_t)tok * 256 + hd * 64 + lane] = f2bf(norm_rope<64>(vfq[hd], fg, rt, 0, 0, lane));
                        fk[(size_t)tok * 256 + hd * 64 + lane] = f2bf(norm_rope<64>(vfk[hd], fg + 64, rt, 0, 0, lane));
                    }
                    const float* dg = p.in[17] + (size_t)l * 64;
#pragma unroll
                    for (int hd = 0; hd < 4; ++hd) {
                        dq[(size_t)tok * 256 + hd * 64 + lane] = f2bf(norm_rope<32>(vdq[hd], dg, rt, 8, 24, lane));
                        dkb[(size_t)tok * 256 + hd * 64 + lane] = f2bf(norm_rope<32>(vdk[hd], dg + 32, rt, 8, 24, lane));
                    }
                    }
                    continue;
                }
            }
        } else if (sub == 3 && EN(4)) {
            const int NJ_C = M / 32;
            const int ntn = 4096 / 128;
            const int nrc = (NJ_C + (int)gridDim.x - 1) / (int)gridDim.x;
            for (int kk = 0;; ++kk) {
                const int job = (kk < nrc) ? (int)blockIdx.x + kk * (int)gridDim.x : NJ_C;
                if (kk < nrc && job >= NJ_C) continue;
                if (job < NJ_C) {
                    const int tokb = job * 32, b = tokb / S;
                    float* P = (float*)smem;
                    {
                        f32x4 k0[16], k1[16];
                        const f32x4* kp0 = (const f32x4*)(kcmp + ((size_t)b * 128 + lane) * 64);
                        const f32x4* kp1 = (const f32x4*)(kcmp + ((size_t)b * 128 + (lane < 63 ? lane + 64 : 126)) * 64);
#pragma unroll
                        for (int i = 0; i < 16; ++i) { k0[i] = kp0[i]; k1[i] = kp1[i]; }
#pragma unroll 1
                        for (int ti = 0; ti < 8; ++ti) {
                            const int tok = tokb + wave * 8 + ti, t = tok % S;
                            const int nvis = (t >= 31) ? ((t - 31) / 16 + 1) : 0;
                            const bool v0 = lane < nvis, v1 = (lane + 64) < nvis;
                            float imp = 0.f;
#pragma unroll
                            for (int hd = 0; hd < 4; ++hd) {
                                const float qv = qfnsa[(size_t)tok * 256 + hd * 64 + lane];
                                float s0 = 0.f, s1 = 0.f;
#pragma unroll
                                for (int d = 0; d < 64; ++d) {
                                    const float qd = __builtin_bit_cast(float, __builtin_amdgcn_readlane(__builtin_bit_cast(int, qv), d));
                                    s0 = fmaf(qd, k0[d >> 2][d & 3], s0); s1 = fmaf(qd, k1[d >> 2][d & 3], s1);
                                }
                                s0 = v0 ? s0 * 0.125f : -1e30f; s1 = v1 ? s1 * 0.125f : -1e30f;
                                const float mx = wmax(fmaxf(s0, s1));
                                const float e0 = v0 ? __expf(s0 - mx) : 0.f, e1 = v1 ? __expf(s1 - mx) : 0.f;
                                const float sm_ = wsum(e0 + e1);
                                const float inv = (nvis > 0) ? 1.f / sm_ : 0.f;
                                float* pr_ = P + (wave * 32 + ti * 4 + hd) * 128;
                                pr_[lane] = e0 * inv; pr_[lane + 64] = e1 * inv;
                            }
                            __syncthreads();
                            if (lane < 32) {
#pragma unroll
                                for (int hd = 0; hd < 4; ++hd) {
                                    const float* pr_ = P + (wave * 32 + ti * 4 + hd) * 128;
#pragma unroll
                                    for (int dc = -1; dc <= 3; ++dc) { const int c = 4 * lane + dc; if (c >= 0 && c <= 126) imp += pr_[c]; }
                                }
                            }
                            const int cur = t >> 6, j = lane;
                            float score;
                            if (j * 64 > t) score = -1.f;
                            else if (j == 0 || j == cur || j == cur - 1) score = 1e4f;
                            else score = imp;
                            if (j >= 32) score = -2.f;
                            int cnt = 0;
#pragma unroll
                            for (int i = 0; i < 32; ++i) {
                                const float si = __builtin_bit_cast(float, __builtin_amdgcn_readlane(__builtin_bit_cast(int, score), i));
                                cnt += (si > score || (si == score && i < j)) ? 1 : 0;
                            }
                            const bool sel = (j < 32) && (cnt < 16) && (j * 64 <= t);
                            const unsigned long long bal = __ballot(sel);
                            if (lane == 0) selm[tok] = (unsigned)bal;
                        }
                    }
                    __syncthreads();
                    {
                        float vcol[128];
#pragma unroll
                        for (int c = 0; c < 127; ++c) vcol[c] = vcmp[((size_t)b * 128 + c) * 64 + lane];
                        vcol[127] = 0.f;
#pragma unroll 1
                        for (int pi = 0; pi < 32; ++pi) {
                            const f32x4* pr_ = (const f32x4*)(P + (wave * 32 + pi) * 128);
                            float o0 = 0.f, o1 = 0.f;
#pragma unroll
                            for (int c4 = 0; c4 < 32; ++c4) {
                                const f32x4 pv = pr_[c4];
                                o0 = fmaf(pv[0], vcol[4 * c4], o0); o1 = fmaf(pv[1], vcol[4 * c4 + 1], o1);
                                o0 = fmaf(pv[2], vcol[4 * c4 + 2], o0); o1 = fmaf(pv[3], vcol[4 * c4 + 3], o1);
                            }
                            const int tok = tokb + wave * 8 + (pi >> 2), hd = pi & 3;
                            ocmp[(size_t)tok * 256 + hd * 64 + lane] = o0 + o1;
                        }
                    }
                    __syncthreads();
                } else break;
            }
        } else if (sub == 4 && EN(5)) {
            unsigned* su = (unsigned*)(smem + LDS_BYTES - 16);
            const float lam_init = __builtin_bit_cast(float, __builtin_amdgcn_readfirstlane(__builtin_bit_cast(int, 0.8f - 0.6f * expf(-0.3f * (float)l))));
            const float one_m_lam = __builtin_bit_cast(float, __builtin_amdgcn_readfirstlane(__builtin_bit_cast(int, 1.f - lam_init)));
            float lam;
            {
                const float* lv = p.in[18] + (size_t)l * 128;
                const int j = lane & 31;
                const float a1 = sum32(lv[j] * lv[32 + j]), a2 = sum32(lv[64 + j] * lv[96 + j]);
                lam = expf(a1) - expf(a2) + lam_init;
                lam = __builtin_bit_cast(float, __builtin_amdgcn_readfirstlane(__builtin_bit_cast(int, lam)));
            }
            const int role = (blockIdx.x >= (gridDim.x >> 1)) ? 1 : 0;
#pragma unroll 1
            for (int step = 0; step < 3; ++step) {
            const int what = role ? (step == 0 ? 2 : (step == 1 ? 1 : 0)) : (step == 0 ? 0 : (step == 1 ? 2 : 1));
            if (what == 2) {
            {
                const int ntn = 4096 / 128;
                for (int k = 0;; ++k) {
                    int tm, tn; if (!xcd_unit(k, 16, ntn, tm, tn)) break;
                    f32x16 acc[2][2]; zero_acc(acc);
                    gemm_main<2>(w_g_t, D, RowPlain{tn * 128}, hbuf, D, tm * 128, D / 64, acc, smem, NoHook{}, tid);
                    const int colb = tn * 128 + wr * 64 + 4 * hh, rowb = tm * 128 + wc * 64 + r32;
                    const float* gb = p.in[22] + (size_t)l * 4096 + colb;
                    bf16_t* gub = gates + (size_t)rowb * GLD + colb;
#pragma unroll
                    for (int mt = 0; mt < 2; ++mt)
#pragma unroll
                        for (int g = 0; g < 4; ++g) {
                            const f32x4 bv = *(const f32x4*)(gb + mt * 32 + 8 * g);
#pragma unroll
                            for (int nt = 0; nt < 2; ++nt) {
                                const float s0 = sigmoidf_(acc[mt][nt][4 * g + 0] + bv[0]), s1 = sigmoidf_(acc[mt][nt][4 * g + 1] + bv[1]);
                                const float s2 = sigmoidf_(acc[mt][nt][4 * g + 2] + bv[2]), s3 = sigmoidf_(acc[mt][nt][4 * g + 3] + bv[3]);
                                *(u32x2*)(gub + (size_t)(nt * 32) * GLD + mt * 32 + 8 * g) = (u32x2){pk2(s0, s1), pk2(s2, s3)};
                            }
                        }
                }
            }
            } else for (;;) {
                if (tid == 0) *su = atomicAdd(&ctr[l + 8 * what], 1u);
                __syncthreads();
                const unsigned u = (unsigned)__builtin_amdgcn_readfirstlane((int)*su);
                __syncthreads();
                if (u >= 1024u) break;
                const unsigned uu = 2u * u + (unsigned)what;
                const int qb = 15 - (int)(uu >> 7), rem = uu & 127, type = rem >> 5, bh = rem & 31, b = bh >> 2, hd = bh & 3;
                const int q0 = qb * 128;
                const bf16_t *Qa, *Ka, *Va, *Qb2, *Kb2, *Vb2; int qs, ksr, nks, mode0, mode1, npass; float scale; const float* cu = nullptr;
                if (type == 0) {
                    Qa = Qb2 = qnsa + (size_t)b * S * 256 + hd * 64; qs = 256; ksr = 64; nks = 4; scale = 0.125f; npass = 2; mode0 = 2; mode1 = 3;
                    Ka = ksb + (size_t)b * S * 64; Kb2 = kwb + (size_t)b * S * 64; Va = vts + (size_t)b * 64 * S; Vb2 = vtw + (size_t)b * 64 * S;
                } else if (type == 1) {
                    Qa = Qb2 = fq + (size_t)b * S * 256 + hd * 64; Ka = Kb2 = fk + (size_t)b * S * 256 + hd * 64; Va = Vb2 = fvt + (size_t)bh * 64 * S;
                    qs = 256; ksr = 256; nks = 4; scale = 0.125f; npass = 1; mode0 = mode1 = 1; cu = cumb + (size_t)bh * S;
                } else if (type == 2) {
                    Qa = Qb2 = mq + (size_t)b * S * 384 + hd * 96; Ka = Kb2 = mk + (size_t)b * S * 384 + hd * 96; Va = Vb2 = mvt + (size_t)bh * 64 * S;
                    qs = 384; ksr = 384; nks = 6; scale = 0.10206207261596577f; npass = 1; mode0 = mode1 = 0;
                } else {
                    Qa = dq + (size_t)b * S * 256 + hd * 64; Qb2 = Qa + 32; Ka = dkb + (size_t)b * S * 256 + hd * 64; Kb2 = Ka + 32; Va = Vb2 = dvt + (size_t)bh * 64 * S;
                    qs = 256; ksr = 256; nks = 2; scale = 0.17677669529663687f; npass = 2; mode0 = mode1 = 0;
                }
                f32x16 O[2];
#pragma nounroll
                for (int pass = 0; pass < npass; ++pass) {
                    attn_pass(pass ? Qb2 : Qa, qs, pass ? Kb2 : Ka, ksr, pass ? Vb2 : Va, cu, selm + (size_t)b * S, scale, nks, pass ? mode1 : mode0, q0, O, smem, wave, lane, tid);
                    if (npass == 2 && pass == 0) {
                        const size_t tok = (size_t)b * S + q0 + wave * 32 + r32;
                        float* tp = ((type == 0) ? ntmp : dtmp) + tok * 256 + hd * 64 + 4 * hh;
                        const float* ocp = ocmp + tok * 256 + hd * 64 + 4 * hh;
                        float g0 = 0.f, g1 = 0.f;
                        if (type == 0) { g0 = gn[tok * 12 + hd]; g1 = gn[tok * 12 + 4 + hd]; }
#pragma unroll
                        for (int dvb = 0; dvb < 2; ++dvb)
#pragma unroll
                            for (int g = 0; g < 4; ++g) {
                                f32x4 v = {O[dvb][4 * g], O[dvb][4 * g + 1], O[dvb][4 * g + 2], O[dvb][4 * g + 3]};
                                f32x4* a = (f32x4*)(tp + dvb * 32 + 8 * g);
                                if (type == 0) { const f32x4 oc = *(const f32x4*)(ocp + dvb * 32 + 8 * g); v = oc * g0 + v * g1; }
                                *a = v;
                            }
                    }
                }
                const int cbase = type * 256;
                const size_t tok = (size_t)b * S + q0 + wave * 32 + r32;
                const float* tp = ((type == 0) ? ntmp : dtmp) + tok * 256 + hd * 64 + 4 * hh;
                if (type == 0) {
                    const float g2 = gn[tok * 12 + 8 + hd];
#pragma unroll
                    for (int dvb = 0; dvb < 2; ++dvb)
#pragma unroll
                        for (int g = 0; g < 4; ++g) {
                            const f32x4 oc = *(const f32x4*)(tp + dvb * 32 + 8 * g);
#pragma unroll
                            for (int e = 0; e < 4; ++e) O[dvb][4 * g + e] = oc[e] + g2 * O[dvb][4 * g + e];
                        }
                } else if (type == 3) {
                    float ss = 0.f;
#pragma unroll
                    for (int dvb = 0; dvb < 2; ++dvb)
#pragma unroll
                        for (int g = 0; g < 4; ++g) {
                            const f32x4 oc = *(const f32x4*)(tp + dvb * 32 + 8 * g);
#pragma unroll
                            for (int e = 0; e < 4; ++e) { const float r = oc[e] - lam * O[dvb][4 * g + e]; O[dvb][4 * g + e] = r; ss += r * r; }
                        }
                    ss += __shfl_xor(ss, 32);
                    const float rstd = rsqrtf(ss * (1.f / 64.f) + EPS);
                    const float* og = p.in[19] + (size_t)l * 64;
#pragma unroll
                    for (int dvb = 0; dvb < 2; ++dvb)
#pragma unroll
                        for (int g = 0; g < 4; ++g) {
                            const f32x4 gg = *(const f32x4*)(og + dvb * 32 + 8 * g + 4 * hh);
#pragma unroll
                            for (int e = 0; e < 4; ++e) O[dvb][4 * g + e] *= rstd * (gg[e] * one_m_lam);
                        }
                }
                store_o(obuf + tok * 1024 + cbase + hd * 64, O, hh);
            }
            }
        } else if (sub == 5 && EN(6)) {
            const int ntn = D / 128;
            for (int k = 0;; ++k) {
                int tm, tn; if (!xcd_unit(k, 16, ntn, tm, tn)) break;
                f32x16 acc[2][2], mg[2][2]; zero_acc(acc); zero_acc(mg);
                const int colb = tn * 128 + wr * 64 + 4 * hh, rowb = tm * 128 + wc * 64 + r32;
                const bf16_t* gub = gates + (size_t)rowb * GLD + colb;
                auto hook = [&](int kt, f32x16 (&a)[2][2]) {
                    if ((kt & 3) == 3) {
                        const bf16_t* gu = gub + (kt >> 2) * 1024;
#pragma unroll
                        for (int mt = 0; mt < 2; ++mt)
#pragma unroll
                            for (int nt = 0; nt < 2; ++nt)
#pragma unroll
                                for (int g = 0; g < 4; ++g) {
                                    const u32x2 gv = *(const u32x2*)(gu + (size_t)(nt * 32) * GLD + mt * 32 + 8 * g);
                                    mg[mt][nt][4 * g + 0] += __uint_as_float(gv[0] << 16) * a[mt][nt][4 * g + 0];
                                    mg[mt][nt][4 * g + 1] += __uint_as_float(gv[0] & 0xffff0000u) * a[mt][nt][4 * g + 1];
                                    mg[mt][nt][4 * g + 2] += __uint_as_float(gv[1] << 16) * a[mt][nt][4 * g + 2];
                                    mg[mt][nt][4 * g + 3] += __uint_as_float(gv[1] & 0xffff0000u) * a[mt][nt][4 * g + 3];
                                    a[mt][nt][4 * g + 0] = 0.f; a[mt][nt][4 * g + 1] = 0.f; a[mt][nt][4 * g + 2] = 0.f; a[mt][nt][4 * g + 3] = 0.f;
                                }
                    }
                };
                gemm_main1<2>(w_br_t, D, RowPlain{tn * 128}, obuf, D, tm * 128, D / 64, acc, smem, hook, tid);
                bf16_t* hub = hbuf + (size_t)rowb * D + colb;
#pragma unroll
                for (int mt = 0; mt < 2; ++mt)
#pragma unroll
                    for (int nt = 0; nt < 2; ++nt)
#pragma unroll
                        for (int g = 0; g < 4; ++g) {
                            u32x2 w = {pk2(mg[mt][nt][4 * g], mg[mt][nt][4 * g + 1]), pk2(mg[mt][nt][4 * g + 2], mg[mt][nt][4 * g + 3])};
                            *(u32x2*)(hub + (size_t)(nt * 32) * D + mt * 32 + 8 * g) = w;
                        }
            }
        } else if ((sub == 6 || sub == 9) && EN(7)) {
            const int ntn = D / 128;
            const bf16_t* A = (sub == 6) ? hbuf : abuf;
            const int lda = (sub == 6) ? D : DFF;
            const bf16_t* Bt = (sub == 6) ? w_o_t : w_dn_t;
            const float* xs = (sub == 6) ? xcur : xo;
            const int og = (sub == 6) ? 2048 : 5120;
            for (int k = 0;; ++k) {
                int tm, tn; if (!xcd_unit(k, 16, ntn, tm, tn)) break;
                f32x16 acc[2][2]; zero_acc(acc);
                gemm_main<2>(A, lda, RowPlain{tm * 128}, Bt, lda, tn * 128, lda / 64, acc, smem, NoHook{}, tid);
                const float* mb = modl + (size_t)(tm * 128 / S) * 6144 + og;
#pragma unroll
                for (int mt = 0; mt < 2; ++mt)
#pragma unroll
                    for (int nt = 0; nt < 2; ++nt)
#pragma unroll
                        for (int i = 0; i < 16; ++i) {
                            const int row = tm * 128 + wr * 64 + mt * 32 + crow(i, hh), col = tn * 128 + wc * 64 + nt * 32 + r32;
                            xo[(size_t)row * D + col] = xs[(size_t)row * D + col] + mb[col] * acc[mt][nt][i];
                        }
            }
        } else if (sub == 8 && EN(8)) {
            const int ntn = 44, ntm = 17;
            const float* cw = p.in[25] + (size_t)l * 3 * DFF;
            const float* cb = p.in[26] + (size_t)l * DFF;
            float* gl = (float*)smem;
            for (int k = 0;; ++k) {
                int tmg, tn; if (!xcd_unit(k, ntm, ntn, tmg, tn)) break;
                const int b = tmg / ntm, tmm = tmg - b * ntm;
                const int t0 = tmm * 126 - 2;
                f32x16 acc[2][2]; zero_acc(acc);
                gemm_main<2>(hbuf, D, RowClamp{b * S, t0}, w_up_t, D, tn * 128, D / 64, acc, smem, NoHook{}, tid);
                {
                    float* wl = gl + (wr * 64 + 4 * hh) * 129 + wc * 64 + r32;
#pragma unroll
                    for (int mt = 0; mt < 2; ++mt)
#pragma unroll
                        for (int nt = 0; nt < 2; ++nt)
#pragma unroll
                            for (int i = 0; i < 16; ++i) wl[(mt * 32 + (i & 3) + 8 * (i >> 2)) * 129 + nt * 32] = acc[mt][nt][i];
                }
                __syncthreads();
                {
                    const int cc = tid & 63, rs = (tid >> 6) * 32, ch = tn * 64 + cc;
                    const float w0 = cw[ch], w1 = cw[DFF + ch], w2 = cw[2 * DFF + ch], bb = cb[ch];
                    float ga = 0.f, gb2 = 0.f;
                    if (rs >= 2) { ga = gl[(rs - 2) * 129 + cc]; gb2 = gl[(rs - 1) * 129 + cc]; }
                    bf16_t* ap = abuf + ((ptrdiff_t)(b * S + t0 + rs)) * DFF + ch;
#pragma unroll 4
                    for (int k = 0; k < 32; ++k) {
                        const int r = rs + k, t = t0 + r;
                        float gc = gl[r * 129 + cc];
                        if (t < 0) gc = 0.f;
                        const float vv = gl[r * 129 + 64 + cc];
                        if (r >= 2 && t < S) ap[(ptrdiff_t)k * DFF] = f2bf(siluf_(w0 * ga + w1 * gb2 + w2 * gc + bb) * vv);
                        ga = gb2; gb2 = gc;
                    }
                }
                __syncthreads();
            }
        }
        if (PROBE_SUB >= 0 || PROBE_MASK != 0u) { if ((sub == PROBE_SUB || ((PROBE_MASK >> sub) & 1u)) && !probe_second) { probe_second = true; --ph; } else probe_second = false; }
    }
}

extern "C" void kernel_launch(void* const* d_in, const int* in_sizes, int n_in, void* d_out, int out_size, void* d_ws, size_t ws_size, hipStream_t stream) {
    static int grid = 0;
    if (grid == 0) {
        if (n_in != 28 || ws_size < WS_END) { fprintf(stderr, "kernel_launch: bad inputs n_in %d ws %zu need %zu\n", n_in, ws_size, (size_t)WS_END); grid = -1; return; }
        int dev = 0, cus = 0, per_cu = 0;
        hipGetDevice(&dev);
        hipDeviceGetAttribute(&cus, hipDeviceAttributeMultiprocessorCount, dev);
        if (hipFuncSetAttribute((const void*)mega, hipFuncAttributeMaxDynamicSharedMemorySize, LDS_BYTES) != hipSuccess) { fprintf(stderr, "hipFuncSetAttribute failed\n"); grid = -1; return; }
        if (hipOccupancyMaxActiveBlocksPerMultiprocessor(&per_cu, (const void*)mega, NT, LDS_BYTES) != hipSuccess || per_cu < 1) { fprintf(stderr, "occupancy query failed\n"); per_cu = 1; }
        if (per_cu > 2) per_cu = 2;
        grid = cus * per_cu;
    }
    if (grid < 0) return;
    if (hipMemsetAsync((char*)d_ws + WS_CTR, 0, 256, stream) != hipSuccess) { fprintf(stderr, "memset failed\n"); return; }
    if (hipMemsetAsync((char*)d_ws + WS_BAR, 0, 16384, stream) != hipSuccess) { fprintf(stderr, "memset failed\n"); return; }
    Params p{};
    for (int i = 0; i < 28; ++i) p.in[i] = (const float*)d_in[i];
    p.out = (float*)d_out; p.ws = (unsigned char*)d_ws; p.ph_lo = 0; p.ph_hi = 1 + NL * 10;
    void* args[] = {&p};
    hipError_t e = hipLaunchCooperativeKernel((const void*)mega, dim3(grid), dim3(NT), args, LDS_BYTES, stream);
    if (e != hipSuccess) fprintf(stderr, "cooperative launch failed: %s (grid %d)\n", hipGetErrorString(e), grid);
}
```

```cpp
#include <hip/hip_runtime.h>
#include <hip/hip_cooperative_groups.h>
#include <stdint.h>
#include <stdio.h>
#include <math.h>
namespace cg = cooperative_groups;

typedef unsigned short bf16_t;
typedef short bf16x8 __attribute__((ext_vector_type(8)));
typedef short s16x4 __attribute__((ext_vector_type(4)));
typedef float f32x16 __attribute__((ext_vector_type(16)));
typedef float f32x4 __attribute__((ext_vector_type(4)));
typedef float f32x2 __attribute__((ext_vector_type(2)));
typedef unsigned u32x4 __attribute__((ext_vector_type(4)));
typedef unsigned u32x2 __attribute__((ext_vector_type(2)));
typedef __bf16 bfv2 __attribute__((ext_vector_type(2)));

#define DI __device__ __forceinline__
#define MFMA32(a, b, c) __builtin_amdgcn_mfma_f32_32x32x16_bf16((a), (b), (c), 0, 0, 0)

constexpr int NB = 8, S = 2048, D = 1024, M = NB * S, NL = 4;
constexpr int NIN = 2608, NINP = 2688, DFF = 2816;
constexpr float EPS = 1e-6f;
constexpr int NT = 256;

constexpr size_t al256(size_t x) { return (x + 255) & ~(size_t)255; }
constexpr size_t WS_CTR = 0;
constexpr size_t WS_MOD = 256;
constexpr size_t WS_ROPE = al256(WS_MOD + (size_t)NL * NB * 6144 * 4);
constexpr size_t WS_W = al256(WS_ROPE + (size_t)M * 28 * 8);
constexpr size_t W_IN = 0;
constexpr size_t W_G = W_IN + (size_t)NINP * 1024 * 2;
constexpr size_t W_BR = W_G + (size_t)4096 * 1024 * 2;
constexpr size_t W_O = W_BR + (size_t)1024 * 1024 * 2;
constexpr size_t W_UP = W_O + (size_t)1024 * 1024 * 2;
constexpr size_t W_DN = W_UP + (size_t)5632 * 1024 * 2;
constexpr size_t W_UQ = W_DN + (size_t)1024 * 2816 * 2;
constexpr size_t W_UKV = W_UQ + (size_t)384 * 256 * 2;
constexpr size_t W_END = W_UKV + (size_t)512 * 128 * 2;
constexpr size_t WS_H = al256(WS_W + W_END);
constexpr size_t WS_R1 = al256(WS_H + (size_t)M * 1024 * 2);
constexpr size_t R1_GATES = 0;
constexpr int GLD = 4160;
constexpr size_t R1_OBUF = (size_t)M * GLD * 2;
constexpr size_t R1_ABUF = 0;
constexpr size_t WS_R2 = al256(WS_R1 + (size_t)M * NINP * 4);
constexpr size_t R2_QNSA = 0;
constexpr size_t R2_QFNSA = R2_QNSA + (size_t)M * 256 * 2;
constexpr size_t R2_KS = R2_QFNSA + (size_t)M * 256 * 4;
constexpr size_t R2_KW = R2_KS + (size_t)M * 64 * 2;
constexpr size_t R2_VTS = R2_KW + (size_t)M * 64 * 2;
constexpr size_t R2_VTW = R2_VTS + (size_t)M * 64 * 2;
constexpr size_t R2_GN = R2_VTW + (size_t)M * 64 * 2;
constexpr size_t R2_KCMP = R2_GN + (size_t)M * 12 * 4;
constexpr size_t R2_VCMP = R2_KCMP + (size_t)NB * 128 * 64 * 4;
constexpr size_t R2_OCMP = R2_VCMP + (size_t)NB * 128 * 64 * 4;
constexpr size_t R2_SELM = R2_OCMP + (size_t)M * 256 * 4;
constexpr size_t R2_FQ = R2_SELM + (size_t)M * 4;
constexpr size_t R2_FK = R2_FQ + (size_t)M * 256 * 2;
constexpr size_t R2_FVT = R2_FK + (size_t)M * 256 * 2;
constexpr size_t R2_CUM = R2_FVT + (size_t)M * 256 * 2;
constexpr size_t R2_MQ = R2_CUM + (size_t)NB * 4 * S * 4;
constexpr size_t R2_MK = R2_MQ + (size_t)M * 384 * 2;
constexpr size_t R2_MVT = R2_MK + (size_t)M * 384 * 2;
constexpr size_t R2_DQ = R2_MVT + (size_t)M * 256 * 2;
constexpr size_t R2_DK = R2_DQ + (size_t)M * 256 * 2;
constexpr size_t R2_DVT = R2_DK + (size_t)M * 256 * 2;
constexpr size_t R2_DTMP = R2_DVT + (size_t)M * 256 * 2;
constexpr size_t R2_NTMP = R2_DTMP + (size_t)M * 256 * 4;
constexpr size_t R2_END = R2_NTMP + (size_t)M * 256 * 4;
constexpr size_t WS_BAR = al256(WS_R2 + R2_END);
constexpr size_t WS_END = WS_BAR + 16384;

constexpr int LDS_BYTES = 73728;
#ifndef PROBE_SUB
#define PROBE_SUB (-1)
#endif
#ifndef PROBE_MASK
#define PROBE_MASK 0u
#endif
#ifndef EN_MASK
#define EN_MASK 0xffffu
#endif
#define EN(k) ((EN_MASK >> (k)) & 1u)
#ifndef TY_MASK
#define TY_MASK 0xfu
#endif
#define TY(k) ((TY_MASK >> (k)) & 1u)

struct Params {
    const float* in[28];
    float* out;
    unsigned char* ws;
    int ph_lo, ph_hi;
};

DI unsigned pk2(float a, float b) { f32x2 v = {a, b}; bfv2 r = __builtin_convertvector(v, bfv2); return __builtin_bit_cast(unsigned, r); }
DI bf16_t f2bf(float a) { return (bf16_t)(pk2(a, 0.f) & 0xffffu); }
DI float bf2f(bf16_t v) { return __uint_as_float(((unsigned)v) << 16); }
template <int CTRL> DI float dpp_f(float v) { return __builtin_bit_cast(float, __builtin_amdgcn_update_dpp(0, __builtin_bit_cast(int, v), CTRL, 0xf, 0xf, true)); }
DI float sum16_dpp(float v) {
    v += dpp_f<0xB1>(v);
    v += dpp_f<0x4E>(v);
    v += dpp_f<0x141>(v);
    v += dpp_f<0x140>(v);
    return v;
}
DI float wsum(float v) {
    v = sum16_dpp(v);
    v += __shfl_xor(v, 16);
    v += __shfl_xor(v, 32);
    return v;
}
DI float wmax(float v) {
#pragma unroll
    for (int o = 1; o < 64; o <<= 1) v = fmaxf(v, __shfl_xor(v, o));
    return v;
}
DI float sum32(float v) {
    v = sum16_dpp(v);
    v += __shfl_xor(v, 16);
    return v;
}
DI float sigmoidf_(float x) { return __builtin_amdgcn_rcpf(1.f + __builtin_amdgcn_exp2f(-1.4426950408889634f * x)); }
DI float siluf_(float x) { return x * __builtin_amdgcn_rcpf(1.f + __builtin_amdgcn_exp2f(-1.4426950408889634f * x)); }
DI int crow(int i, int hh) { return (i & 3) + 8 * (i >> 2) + 4 * hh; }

DI void tc_tile(const float* __restrict__ src, int ld, int nvalid, int k0, int n0, bf16_t* __restrict__ dst, int ldd, int drow0, float* sm, int tid) {
#pragma unroll
    for (int p = 0; p < 4; ++p) {
        const int r = p * 16 + (tid >> 4), c4 = (tid & 15) * 4;
        f32x4 v = {0.f, 0.f, 0.f, 0.f};
        if (n0 + c4 < nvalid) v = *(const f32x4*)(src + (size_t)(k0 + r) * ld + n0 + c4);
        sm[r * 65 + c4 + 0] = v[0]; sm[r * 65 + c4 + 1] = v[1]; sm[r * 65 + c4 + 2] = v[2]; sm[r * 65 + c4 + 3] = v[3];
    }
    __syncthreads();
    const int n = tid >> 2, ks = (tid & 3) * 16;
    unsigned w[8];
#pragma unroll
    for (int i = 0; i < 8; ++i) w[i] = pk2(sm[(ks + 2 * i) * 65 + n], sm[(ks + 2 * i + 1) * 65 + n]);
    u32x4* d = (u32x4*)(dst + (size_t)(drow0 + n) * ldd + k0 + ks);
    d[0] = (u32x4){w[0], w[1], w[2], w[3]};
    d[1] = (u32x4){w[4], w[5], w[6], w[7]};
    __syncthreads();
}

DI void tc_matrix(const float* src, int K, int N, bf16_t* dst, int ldd, float* sm, int mode  , int tid) {
    const int nkt = K / 64, nnt = (N + 63) / 64;
    for (int j = blockIdx.x; j < nkt * nnt; j += gridDim.x) {
        const int tn = j / nkt, tk = j % nkt;
        int drow0 = tn * 64;
        if (mode == 1) drow0 = (tn < 44) ? tn * 128 : (tn - 44) * 128 + 64;
        tc_tile(src, N, N, tk * 64, tn * 64, dst, ldd, drow0, sm, tid);
    }
}

struct NoHook { template <class T> DI void operator()(int, T&) const {} };

template <int NTW, class AR, class HK>
DI void gemm_main(const bf16_t* __restrict__ A, int lda, AR arow, const bf16_t* __restrict__ Bt, int ldb, int col0, int nk,
                  f32x16 (&acc)[2][NTW], unsigned char* smraw, HK hook, int tid) {
    constexpr int BROWS = 64 * NTW, NBL = 2 * NTW;
    bf16_t* sa = (bf16_t*)smraw;
    bf16_t* sb = sa + 2 * 128 * 72;
    const int lane = tid & 63, wave = __builtin_amdgcn_readfirstlane(tid >> 6), wr = wave >> 1, wc = wave & 1, r32 = lane & 31, hh = lane >> 5;
    const int lr = tid >> 3, lc = (tid & 7) * 8;
    const bf16_t* ap[4];
    const bf16_t* bp[NBL];
#pragma unroll
    for (int p = 0; p < 4; ++p) ap[p] = A + (size_t)arow(p * 32 + lr) * lda + lc;
#pragma unroll
    for (int p = 0; p < NBL; ++p) bp[p] = Bt + (size_t)(col0 + p * 32 + lr) * ldb + lc;
    u32x4 ra0[4], rb0[NBL], ra1[4], rb1[NBL];
#define G_LOAD(RA, RB, KT) { _Pragma("unroll") for (int p = 0; p < 4; ++p) RA[p] = *(const u32x4*)(ap[p] + (KT) * 64); _Pragma("unroll") for (int p = 0; p < NBL; ++p) RB[p] = *(const u32x4*)(bp[p] + (KT) * 64); }
#define G_STORE(RA, RB, BUF) { bf16_t* wa = sa + (BUF) * 128 * 72; bf16_t* wb = sb + (BUF) * BROWS * 72; _Pragma("unroll") for (int p = 0; p < 4; ++p) *(u32x4*)(wa + (p * 32 + lr) * 72 + lc) = RA[p]; _Pragma("unroll") for (int p = 0; p < NBL; ++p) *(u32x4*)(wb + (p * 32 + lr) * 72 + lc) = RB[p]; }
#define G_COMPUTE(BUF) { __builtin_amdgcn_s_setprio(1); const bf16_t* ca = sa + (BUF) * 128 * 72 + (wr * 64 + r32) * 72 + hh * 8; const bf16_t* cb = sb + (BUF) * BROWS * 72 + (wc * 32 * NTW + r32) * 72 + hh * 8; \
        _Pragma("unroll") for (int ks = 0; ks < 4; ++ks) { const bf16x8 a0 = *(const bf16x8*)(ca + ks * 16), a1 = *(const bf16x8*)(ca + 32 * 72 + ks * 16); \
            _Pragma("unroll") for (int nt = 0; nt < NTW; ++nt) { const bf16x8 b0 = *(const bf16x8*)(cb + nt * 32 * 72 + ks * 16); acc[0][nt] = MFMA32(a0, b0, acc[0][nt]); acc[1][nt] = MFMA32(a1, b0, acc[1][nt]); } }  __builtin_amdgcn_s_setprio(0); }
    G_LOAD(ra0, rb0, 0);
    G_LOAD(ra1, rb1, 1);
    G_STORE(ra0, rb0, 0);
    __syncthreads();
    for (int kt = 0; kt < nk; kt += 2) {
        if (kt + 2 < nk) G_LOAD(ra0, rb0, kt + 2);
        __builtin_amdgcn_sched_barrier(0);
        G_COMPUTE(0);
        hook(kt, acc);
        G_STORE(ra1, rb1, 1);
        __syncthreads();
        if (kt + 3 < nk) G_LOAD(ra1, rb1, kt + 3);
        __builtin_amdgcn_sched_barrier(0);
        G_COMPUTE(1);
        hook(kt + 1, acc);
        if (kt + 2 < nk) G_STORE(ra0, rb0, 0);
        __syncthreads();
    }
#undef G_LOAD
#undef G_STORE
#undef G_COMPUTE
}

template <int NTW, class AR, class HK>
DI void gemm_main1(const bf16_t* __restrict__ A, int lda, AR arow, const bf16_t* __restrict__ Bt, int ldb, int col0, int nk,
                  f32x16 (&acc)[2][NTW], unsigned char* smraw, HK hook, int tid) {
    constexpr int BROWS = 64 * NTW, NBL = 2 * NTW;
    bf16_t* sa = (bf16_t*)smraw;
    bf16_t* sb = sa + 2 * 128 * 72;
    const int lane = tid & 63, wave = __builtin_amdgcn_readfirstlane(tid >> 6), wr = wave >> 1, wc = wave & 1, r32 = lane & 31, hh = lane >> 5;
    const int lr = tid >> 3, lc = (tid & 7) * 8;
    const bf16_t* ap[4];
    const bf16_t* bp[NBL];
#pragma unroll
    for (int p = 0; p < 4; ++p) ap[p] = A + (size_t)arow(p * 32 + lr) * lda + lc;
#pragma unroll
    for (int p = 0; p < NBL; ++p) bp[p] = Bt + (size_t)(col0 + p * 32 + lr) * ldb + lc;
    u32x4 ra[4], rb[NBL];
#pragma unroll
    for (int p = 0; p < 4; ++p) ra[p] = *(const u32x4*)(ap[p]);
#pragma unroll
    for (int p = 0; p < NBL; ++p) rb[p] = *(const u32x4*)(bp[p]);
#pragma unroll
    for (int p = 0; p < 4; ++p) *(u32x4*)(sa + (p * 32 + lr) * 72 + lc) = ra[p];
#pragma unroll
    for (int p = 0; p < NBL; ++p) *(u32x4*)(sb + (p * 32 + lr) * 72 + lc) = rb[p];
    __syncthreads();
    for (int kt = 0; kt < nk; ++kt) {
        const int buf = kt & 1;
        if (kt + 1 < nk) {
#pragma unroll
            for (int p = 0; p < 4; ++p) ra[p] = *(const u32x4*)(ap[p] + (kt + 1) * 64);
#pragma unroll
            for (int p = 0; p < NBL; ++p) rb[p] = *(const u32x4*)(bp[p] + (kt + 1) * 64);
        }
        __builtin_amdgcn_sched_barrier(0);
        const bf16_t* ca = sa + buf * 128 * 72 + (wr * 64 + r32) * 72 + hh * 8;
        const bf16_t* cb = sb + buf * BROWS * 72 + (wc * 32 * NTW + r32) * 72 + hh * 8;
#pragma unroll
        for (int ks = 0; ks < 4; ++ks) {
            const bf16x8 a0 = *(const bf16x8*)(ca + ks * 16), a1 = *(const bf16x8*)(ca + 32 * 72 + ks * 16);
#pragma unroll
            for (int nt = 0; nt < NTW; ++nt) {
                const bf16x8 b0 = *(const bf16x8*)(cb + nt * 32 * 72 + ks * 16);
                acc[0][nt] = MFMA32(a0, b0, acc[0][nt]);
                acc[1][nt] = MFMA32(a1, b0, acc[1][nt]);
            }
        }
        hook(kt, acc);
        if (kt + 1 < nk) {
            bf16_t* wa = sa + (buf ^ 1) * 128 * 72;
            bf16_t* wb = sb + (buf ^ 1) * BROWS * 72;
#pragma unroll
            for (int p = 0; p < 4; ++p) *(u32x4*)(wa + (p * 32 + lr) * 72 + lc) = ra[p];
#pragma unroll
            for (int p = 0; p < NBL; ++p) *(u32x4*)(wb + (p * 32 + lr) * 72 + lc) = rb[p];
        }
        __syncthreads();
    }
}

struct RowPlain { int r0; DI int operator()(int r) const { return r0 + r; } };
struct RowClamp { int base, t0; DI int operator()(int r) const { int t = t0 + r; t = t < 0 ? 0 : (t > S - 1 ? S - 1 : t); return base + t; } };

DI void zero_acc(f32x16 (&acc)[2][2]) {
#pragma unroll
    for (int a = 0; a < 2; ++a)
#pragma unroll
        for (int b = 0; b < 2; ++b)
#pragma unroll
            for (int i = 0; i < 16; ++i) acc[a][b][i] = 0.f;
}

DI void attn_pass(const bf16_t* __restrict__ Qp, int qs, const bf16_t* __restrict__ Kp, int ksr, const bf16_t* __restrict__ Vt,
                  const float* __restrict__ cum, const unsigned* __restrict__ selm, float scale, int nks, int mode, int q0,
                  f32x16 (&O)[2], unsigned char* smraw, int wave, int lane, int tid) {
    constexpr int KROW = 104, KT = 64 * KROW, VT = 64 * 68;
    bf16_t* sK = (bf16_t*)smraw;
    bf16_t* sV = sK + 2 * KT;
    float* sC = (float*)(smraw + 2 * KT * 2 + 2 * VT * 2);
    const int r32 = lane & 31, hh = lane >> 5;
    const int qw = q0 + wave * 32, t = qw + r32;
    bf16x8* sQ = (bf16x8*)(smraw + 2 * KT * 2 + 2 * VT * 2 + 512) + wave * 6 * 64 + lane;
#pragma unroll
    for (int ks = 0; ks < 6; ++ks) if (ks < nks) sQ[ks * 64] = *(const bf16x8*)(Qp + (size_t)t * qs + ks * 16 + hh * 8);
    float cq = 0.f; unsigned smk = 0xffffffffu;
    if (mode == 1) cq = cum[t];
    if (mode == 2) smk = selm[t];
    const int win = (mode == 3) ? 512 : (1 << 30);
    const float c2 = scale * 1.4426950408889634f, ic2 = 1.f / scale;
    int kt0 = 0; const int kt1 = q0 / 64 + 2;
    if (mode == 3) { kt0 = q0 / 64 - 8; if (kt0 < 0) kt0 = 0; }
#pragma unroll
    for (int i = 0; i < 16; ++i) { O[0][i] = 0.f; O[1][i] = 0.f; }
    float m = -1e30f, l = 0.f;
    const int nkc = nks >> 1, cpr = nks * 2;
    int krc[3];
#pragma unroll
    for (int p = 0; p < 3; ++p) { const int c = p * 256 + tid, row = c / cpr, cc = c - row * cpr; krc[p] = row | (cc << 8); }
#define KG(p) ((krc[p] & 255) * ksr + (krc[p] >> 8) * 8)
#define KL(p) ((krc[p] & 255) * KROW + (krc[p] >> 8) * 8)
#define VG(p) ((((p) * 256 + tid) >> 3) * S + (((p) * 256 + tid) & 7) * 8)
#define VL(p) ((((p) * 256 + tid) >> 3) * 68 + (((p) * 256 + tid) & 7) * 8)
    u32x4 rk[3], rv[2]; float rc = 0.f;
    {
        const bf16_t* kp = Kp + (size_t)kt0 * 64 * ksr; const bf16_t* vp = Vt + kt0 * 64;
#pragma unroll
        for (int p = 0; p < 3; ++p) if (p < nkc) rk[p] = *(const u32x4*)(kp + KG(p));
#pragma unroll
        for (int p = 0; p < 2; ++p) rv[p] = *(const u32x4*)(vp + VG(p));
        if (mode == 1 && tid < 64) rc = cum[kt0 * 64 + tid];
#pragma unroll
        for (int p = 0; p < 3; ++p) if (p < nkc) *(u32x4*)(sK + KL(p)) = rk[p];
#pragma unroll
        for (int p = 0; p < 2; ++p) { u32x2* d = (u32x2*)(sV + VL(p)); d[0] = (u32x2){rv[p][0], rv[p][1]}; d[1] = (u32x2){rv[p][2], rv[p][3]}; }
        if (mode == 1 && tid < 64) sC[tid] = rc;
    }
    __syncthreads();
    for (int kt = kt0; kt < kt1; ++kt) {
        const int buf = (kt - kt0) & 1;
        if (kt + 1 < kt1) {
            const bf16_t* kp = Kp + (size_t)(kt + 1) * 64 * ksr; const bf16_t* vp = Vt + (kt + 1) * 64;
#pragma unroll
            for (int p = 0; p < 3; ++p) if (p < nkc) rk[p] = *(const u32x4*)(kp + KG(p));
#pragma unroll
            for (int p = 0; p < 2; ++p) rv[p] = *(const u32x4*)(vp + VG(p));
            if (mode == 1 && tid < 64) rc = cum[(kt + 1) * 64 + tid];
        }
        bool act = (kt * 64 <= qw + 31) && (kt * 64 + 63 > qw - win);
        const bool selb = ((smk >> kt) & 1u) != 0u;
        const unsigned long long selbal = __ballot(selb);
        act = act && (selbal != 0ull);
        if (act) {
            const bool full = (kt * 64 + 63 <= qw) && (kt * 64 > qw + 31 - win) && (selbal == ~0ull);
#pragma nounroll
            for (int kb = 0; kb < 2; ++kb) {
                f32x16 Sx;
#pragma unroll
                for (int i = 0; i < 16; ++i) Sx[i] = 0.f;
                const bf16_t* kr = sK + buf * KT + (kb * 32 + r32) * KROW + hh * 8;
#pragma unroll
                for (int ks = 0; ks < 6; ++ks) if (ks < nks) { const bf16x8 a = *(const bf16x8*)(kr + ks * 16); const bf16x8 qv = sQ[ks * 64]; Sx = MFMA32(a, qv, Sx); }
                if (mode == 1) {
#pragma unroll
                    for (int g = 0; g < 4; ++g) {
                        const f32x4 ck = *(const f32x4*)(sC + buf * 64 + kb * 32 + 8 * g + 4 * hh);
#pragma unroll
                        for (int e = 0; e < 4; ++e) Sx[4 * g + e] += (cq - ck[e]) * ic2;
                    }
                }
                if (!full) {
                    const int kbase = kt * 64 + kb * 32 + 4 * hh;
#pragma unroll
                    for (int i = 0; i < 16; ++i) {
                        const int key = kbase + (i & 3) + 8 * (i >> 2);
                        const bool ok = (key <= t) && (key > t - win) && selb;
                        Sx[i] = ok ? Sx[i] : -3e38f;
                    }
                }
                float mx = -3e38f;
#pragma unroll
                for (int i = 0; i < 16; ++i) mx = fmaxf(mx, Sx[i]);
                mx = fmaxf(mx, __shfl_xor(mx, 32));
                mx = fmaxf(mx * c2, -1e30f);
                if (__ballot(mx - m > 10.0f) != 0ull) {
                    const float mn = fmaxf(m, mx), alpha = __builtin_amdgcn_exp2f(m - mn);
                    m = mn;
#pragma unroll
                    for (int i = 0; i < 16; ++i) { O[0][i] *= alpha; O[1][i] *= alpha; }
                    l *= alpha;
                }
                const float mneg = -m;
                float rs = 0.f;
#pragma unroll
                for (int i = 0; i < 16; ++i) { const float pp = __builtin_amdgcn_exp2f(fmaf(Sx[i], c2, mneg)); Sx[i] = pp; rs += pp; }
                l += rs;
#pragma unroll
                for (int s2 = 0; s2 < 2; ++s2) {
                    u32x4 pw;
                    pw[0] = pk2(Sx[8 * s2 + 0], Sx[8 * s2 + 1]); pw[1] = pk2(Sx[8 * s2 + 2], Sx[8 * s2 + 3]);
                    pw[2] = pk2(Sx[8 * s2 + 4], Sx[8 * s2 + 5]); pw[3] = pk2(Sx[8 * s2 + 6], Sx[8 * s2 + 7]);
                    const bf16x8 pb = __builtin_bit_cast(bf16x8, pw);
#pragma unroll
                    for (int dvb = 0; dvb < 2; ++dvb) {
                        const bf16_t* vr = sV + buf * VT + (dvb * 32 + r32) * 68 + kb * 32 + 16 * s2 + 4 * hh;
                        const s16x4 lo = *(const s16x4*)vr, hi = *(const s16x4*)(vr + 8);
                        const bf16x8 va = __builtin_shufflevector(lo, hi, 0, 1, 2, 3, 4, 5, 6, 7);
                        O[dvb] = MFMA32(va, pb, O[dvb]);
                    }
                }
            }
        }
        if (kt + 1 < kt1) {
            const int nb = buf ^ 1;
#pragma unroll
            for (int p = 0; p < 3; ++p) if (p < nkc) *(u32x4*)(sK + nb * KT + KL(p)) = rk[p];
#pragma unroll
            for (int p = 0; p < 2; ++p) { u32x2* d = (u32x2*)(sV + nb * VT + VL(p)); d[0] = (u32x2){rv[p][0], rv[p][1]}; d[1] = (u32x2){rv[p][2], rv[p][3]}; }
            if (mode == 1 && tid < 64) sC[nb * 64 + tid] = rc;
        }
        __syncthreads();
    }
    l += __shfl_xor(l, 32);
    const float inv = 1.f / l;
#pragma unroll
    for (int i = 0; i < 16; ++i) { O[0][i] *= inv; O[1][i] *= inv; }
}

DI void store_o(bf16_t* dst, const f32x16 (&O)[2], int hh) {
#pragma unroll
    for (int dvb = 0; dvb < 2; ++dvb)
#pragma unroll
        for (int g = 0; g < 4; ++g) {
            u32x2 w = {pk2(O[dvb][4 * g], O[dvb][4 * g + 1]), pk2(O[dvb][4 * g + 2], O[dvb][4 * g + 3])};
            *(u32x2*)(dst + dvb * 32 + 8 * g + 4 * hh) = w;
        }
}

template <int GW>
DI float norm_rope(float v, const float* __restrict__ gain, const f32x2* __restrict__ rope_tok, int nrot, int ra, int lane) {
    float ss = v * v;
    ss = (GW == 64) ? wsum(ss) : sum32(ss);
    const int j = lane & (GW - 1);
    float y = v * rsqrtf(ss * (1.f / GW) + EPS) * gain[j];
    if (nrot) {
        const int half = nrot >> 1;
        const float partner = __shfl_xor(y, half);
        if (j < nrot) {
            const f32x2 cs = rope_tok[ra + (j & (half - 1))];
            y = (j < half) ? (y * cs[0] - partner * cs[1]) : (y * cs[0] + partner * cs[1]);
        }
    }
    return y;
}

DI bool xcd_unit(int k, int R, int ntn, int& tmg, int& tn) {
    const int x = blockIdx.x & 7, j = (int)(blockIdx.x >> 3) + k * (int)(gridDim.x >> 3);
    if (j >= R * ntn) return false;
    const int g0 = (R + 1) >> 1;
    int w = j, r0 = 0, gs = g0;
    if (j >= g0 * ntn) { w = j - g0 * ntn; r0 = g0; gs = R - g0; }
    tn = w / gs; tmg = x * R + r0 + (w - tn * gs);
    return true;
}

DI unsigned xb_ld(unsigned* p) { return __hip_atomic_load(p, __ATOMIC_RELAXED, __HIP_MEMORY_SCOPE_AGENT); }
DI unsigned xb_add(unsigned* p, unsigned v) { return __hip_atomic_fetch_add(p, v, __ATOMIC_RELAXED, __HIP_MEMORY_SCOPE_AGENT); }
DI unsigned xcc_id() { return (unsigned)__builtin_amdgcn_s_getreg((3 << 11) | 20) & 0xFu; }
DI void xbar(unsigned* bar, unsigned x, unsigned nloc, unsigned nx, int tid) {
    asm volatile("s_waitcnt vmcnt(0)" ::: "memory");
    __syncthreads();
    if (tid == 0) {
        __builtin_amdgcn_s_waitcnt(0);
        const unsigned old = xb_add(&bar[1024 + 64 * x], 1u);
        const unsigned gen = old / nloc;
        if (old + 1u == (gen + 1u) * nloc) {
            __builtin_amdgcn_fence(__ATOMIC_RELEASE, "agent");
            asm volatile("s_waitcnt vmcnt(0)" ::: "memory");
            const unsigned og = xb_add(&bar[3072], 1u);
            const unsigned tg = og / nx;
            if (og + 1u == (tg + 1u) * nx) xb_add(&bar[3136], 1u);
            else while (xb_ld(&bar[3136]) == tg) __builtin_amdgcn_s_sleep(1);
            __builtin_amdgcn_fence(__ATOMIC_ACQUIRE, "agent");
            xb_add(&bar[2048 + 64 * x], 1u);
            asm volatile("s_waitcnt vmcnt(0)" ::: "memory");
        } else {
            while (xb_ld(&bar[2048 + 64 * x]) == gen) __builtin_amdgcn_s_sleep(1);
            __builtin_amdgcn_fence(__ATOMIC_ACQUIRE, "agent");
            asm volatile("s_waitcnt vmcnt(0)" ::: "memory");
        }
    }
    __syncthreads();
}

__global__ void __launch_bounds__(NT, 2) mega(Params p) {
    extern __shared__ __attribute__((aligned(16))) unsigned char smem[];
    cg::grid_group grid = cg::this_grid();
    bool probe_second = false;
    int nbar = 0;
    unsigned* xbw = (unsigned*)(p.ws + WS_BAR);
    const unsigned xcc = (unsigned)__builtin_amdgcn_readfirstlane((int)xcc_id());
    unsigned xb_nloc = 1u, xb_nx = 1u;
    if (threadIdx.x == 0) xb_add(&xbw[64 * xcc], 1u);
    const int wave_s = __builtin_amdgcn_readfirstlane((int)(threadIdx.x >> 6));
    for (int ph = p.ph_lo; ph < p.ph_hi; ++ph) {
        int zop = 0; asm volatile("" : "+s"(zop));
        const int tid = wave_s * 64 + (int)__builtin_amdgcn_mbcnt_hi(~0u, __builtin_amdgcn_mbcnt_lo(~0u, (unsigned)zop));
        if (ph > p.ph_lo || probe_second) {
            if (nbar == 0) {
                grid.sync();
                unsigned cnt = 0u, mine = 1u;
                for (unsigned j = 0; j < 16; ++j) { const unsigned c = xb_ld(&xbw[64 * j]); cnt += (c > 0u) ? 1u : 0u; if (j == xcc) mine = c; }
                xb_nloc = (unsigned)__builtin_amdgcn_readfirstlane((int)(mine > 0u ? mine : 1u));
                xb_nx = (unsigned)__builtin_amdgcn_readfirstlane((int)(cnt > 0u ? cnt : 1u));
            } else xbar(xbw, xcc, xb_nloc, xb_nx, tid);
            ++nbar;
        }
        const int lane = tid & 63, wave = __builtin_amdgcn_readfirstlane(tid >> 6), r32 = lane & 31, hh = lane >> 5;
        const int wr = wave >> 1, wc = wave & 1;
        unsigned char* ws = p.ws;
        unsigned* ctr = (unsigned*)(ws + WS_CTR);
        float* modb = (float*)(ws + WS_MOD);
        f32x2* rope = (f32x2*)(ws + WS_ROPE);
        bf16_t* Wb = (bf16_t*)(ws + WS_W);
        bf16_t* w_in_t = (bf16_t*)(ws + WS_W + W_IN);
        bf16_t* w_g_t = (bf16_t*)(ws + WS_W + W_G);
        bf16_t* w_br_t = (bf16_t*)(ws + WS_W + W_BR);
        bf16_t* w_o_t = (bf16_t*)(ws + WS_W + W_O);
        bf16_t* w_up_t = (bf16_t*)(ws + WS_W + W_UP);
        bf16_t* w_dn_t = (bf16_t*)(ws + WS_W + W_DN);
        bf16_t* w_uq_t = (bf16_t*)(ws + WS_W + W_UQ);
        bf16_t* w_ukv_t = (bf16_t*)(ws + WS_W + W_UKV);
        (void)Wb;
        bf16_t* hbuf = (bf16_t*)(ws + WS_H);
        float* parts = (float*)(ws + WS_R1);
        bf16_t* gates = (bf16_t*)(ws + WS_R1 + R1_GATES);
        bf16_t* obuf = (bf16_t*)(ws + WS_R1 + R1_OBUF);
        bf16_t* abuf = (bf16_t*)(ws + WS_R1 + R1_ABUF);
        unsigned char* r2 = ws + WS_R2;
        bf16_t* qnsa = (bf16_t*)(r2 + R2_QNSA);
        float* qfnsa = (float*)(r2 + R2_QFNSA);
        bf16_t* ksb = (bf16_t*)(r2 + R2_KS);
        bf16_t* kwb = (bf16_t*)(r2 + R2_KW);
        bf16_t* vts = (bf16_t*)(r2 + R2_VTS);
        bf16_t* vtw = (bf16_t*)(r2 + R2_VTW);
        float* gn = (float*)(r2 + R2_GN);
        float* kcmp = (float*)(r2 + R2_KCMP);
        float* vcmp = (float*)(r2 + R2_VCMP);
        float* ocmp = (float*)(r2 + R2_OCMP);
        unsigned* selm = (unsigned*)(r2 + R2_SELM);
        bf16_t* fq = (bf16_t*)(r2 + R2_FQ);
        bf16_t* fk = (bf16_t*)(r2 + R2_FK);
        bf16_t* fvt = (bf16_t*)(r2 + R2_FVT);
        float* cumb = (float*)(r2 + R2_CUM);
        bf16_t* mq = (bf16_t*)(r2 + R2_MQ);
        bf16_t* mk = (bf16_t*)(r2 + R2_MK);
        bf16_t* mvt = (bf16_t*)(r2 + R2_MVT);
        bf16_t* dq = (bf16_t*)(r2 + R2_DQ);
        bf16_t* dkb = (bf16_t*)(r2 + R2_DK);
        bf16_t* dvt = (bf16_t*)(r2 + R2_DVT);
        float* dtmp = (float*)(r2 + R2_DTMP);
        float* ntmp = (float*)(r2 + R2_NTMP);

        const float* x_in = p.in[0];
        const float* c_in = p.in[1];
        const int* pos_in = (const int*)p.in[2];
        float* xo = p.out;

        if (ph == 0) {
            if (!EN(0)) continue;
            if (blockIdx.x == 0 && tid < 16) ctr[tid] = 0u;
            for (int idx = blockIdx.x * NT + tid; idx < M * 28; idx += gridDim.x * NT) {
                const int tok = idx / 28, a = idx % 28;
                float e;
                if (a < 8) e = -(float)a / 8.f; else if (a < 24) e = -(float)(a - 8) / 16.f; else e = -(float)(a - 24) / 4.f;
                const float inv_freq = powf(500000.f, e);
                const float ang = (float)pos_in[tok] * inv_freq;
                rope[idx] = (f32x2){cosf(ang), sinf(ang)};
            }
            float* sc = (float*)smem;
            float* red = sc + 8 * 1024;
            for (int i = tid; i < 8192; i += NT) sc[i] = siluf_(c_in[i]);
            __syncthreads();
            for (int job = blockIdx.x; job < NL * 96; job += gridDim.x) {
                const int l = job / 96, cgp = job % 96;
                const int kq = tid >> 6, j = tid & 63, col = cgp * 64 + j;
                float acc[8];
#pragma unroll
                for (int b = 0; b < 8; ++b) acc[b] = 0.f;
                const float* wp = p.in[3] + ((size_t)l * 1024 + kq * 256) * 6144 + col;
                for (int k = 0; k < 256; ++k) {
                    const float w = wp[(size_t)k * 6144];
#pragma unroll
                    for (int b = 0; b < 8; ++b) acc[b] += sc[b * 1024 + kq * 256 + k] * w;
                }
#pragma unroll
                for (int b = 0; b < 8; ++b) red[(kq * 8 + b) * 64 + j] = acc[b];
                __syncthreads();
                if (kq == 0) {
#pragma unroll
                    for (int b = 0; b < 8; ++b) {
                        const float v = red[(0 * 8 + b) * 64 + j] + red[(1 * 8 + b) * 64 + j] + red[(2 * 8 + b) * 64 + j] + red[(3 * 8 + b) * 64 + j];
                        modb[((size_t)l * 8 + b) * 6144 + col] = v + p.in[4][l * 6144 + col];
                    }
                }
                __syncthreads();
            }
            if (PROBE_SUB == 100 && !probe_second) { probe_second = true; --ph; } else probe_second = false;
            continue;
        }
        const int l = (ph - 1) / 10, sub = (ph - 1) % 10;
        const float* xcur = (l == 0) ? x_in : xo;
        const float* modl = modb + (size_t)l * 8 * 6144;
        if ((sub == 0 || sub == 7) && EN(1)) {
            if (sub == 0) {
                float* tsm = (float*)smem;
                tc_matrix(p.in[5] + (size_t)l * 1024 * NIN, 1024, NIN, w_in_t, 1024, tsm, 0, tid);
                for (int i = blockIdx.x * NT + tid; i < 64 * 1024 / 8; i += gridDim.x * NT) ((u32x4*)(w_in_t + (size_t)2624 * 1024))[i] = (u32x4){0u, 0u, 0u, 0u};
                tc_matrix(p.in[21] + (size_t)l * 1024 * 4096, 1024, 4096, w_g_t, 1024, tsm, 0, tid);
                tc_matrix(p.in[20] + (size_t)l * 1024 * 1024, 1024, 1024, w_br_t, 1024, tsm, 0, tid);
                tc_matrix(p.in[23] + (size_t)l * 1024 * 1024, 1024, 1024, w_o_t, 1024, tsm, 0, tid);
                tc_matrix(p.in[24] + (size_t)l * 1024 * 5632, 1024, 5632, w_up_t, 1024, tsm, 1, tid);
                tc_matrix(p.in[27] + (size_t)l * DFF * 1024, DFF, 1024, w_dn_t, DFF, tsm, 0, tid);
                tc_matrix(p.in[14] + (size_t)l * 256 * 384, 256, 384, w_uq_t, 256, tsm, 0, tid);
                tc_matrix(p.in[15] + (size_t)l * 128 * 512, 128, 512, w_ukv_t, 128, tsm, 0, tid);
            }
            const float* xs = (sub == 0) ? xcur : xo;
            const int osh = (sub == 0) ? 0 : 3072, osc = osh + 1024;
            for (int tok = blockIdx.x * 4 + wave; tok < M; tok += gridDim.x * 4) {
                const int b = tok / S;
                const f32x4* xr = (const f32x4*)(xs + (size_t)tok * D);
                f32x4 v[4]; float ss = 0.f;
#pragma unroll
                for (int i = 0; i < 4; ++i) { v[i] = xr[lane + 64 * i]; ss += v[i][0] * v[i][0] + v[i][1] * v[i][1] + v[i][2] * v[i][2] + v[i][3] * v[i][3]; }
                ss = wsum(ss);
                const float rstd = rsqrtf(ss * (1.f / D) + EPS);
                const float* mb = modl + (size_t)b * 6144;
#pragma unroll
                for (int i = 0; i < 4; ++i) {
                    const int col = (lane + 64 * i) * 4;
                    const f32x4 scv = *(const f32x4*)(mb + osc + col), shv = *(const f32x4*)(mb + osh + col);
                    float o[4];
#pragma unroll
                    for (int e = 0; e < 4; ++e) o[e] = v[i][e] * rstd * (1.f + scv[e]) + shv[e];
                    *(u32x2*)(hbuf + (size_t)tok * D + col) = (u32x2){pk2(o[0], o[1]), pk2(o[2], o[3])};
                }
            }
        } else if (sub == 1 && EN(2)) {
            const int ntn = NINP / 128;
            for (int k = 0;; ++k) {
                int tm, tn; if (!xcd_unit(k, 16, ntn, tm, tn)) break;
                f32x16 acc[2][2]; zero_acc(acc);
                gemm_main<2>(hbuf, D, RowPlain{tm * 128}, w_in_t, D, tn * 128, D / 64, acc, smem, NoHook{}, tid);
#pragma unroll
                for (int mt = 0; mt < 2; ++mt)
#pragma unroll
                    for (int nt = 0; nt < 2; ++nt)
#pragma unroll
                        for (int i = 0; i < 16; ++i) {
                            const int row = tm * 128 + wr * 64 + mt * 32 + crow(i, hh), col = tn * 128 + wc * 64 + nt * 32 + r32;
                            parts[(size_t)row * NINP + col] = acc[mt][nt][i];
                        }
            }
        } else if (sub == 2 && EN(3)) {
            const int NJ_MLA = 2 * (M / 64), NJ_CMP = NB * 2 * 32, NJ_TC = 10 * (M / 256), NJ_TOK = M / 32, NJ_CUM = 8;
            const int NJ = NJ_MLA + NJ_CMP + NJ_TC + NJ_TOK + NJ_CUM;
            unsigned* sj = (unsigned*)(smem + LDS_BYTES - 16);
            for (;;) {
                __syncthreads();
                if (tid == 0) *sj = atomicAdd(&ctr[16 + l + (probe_second ? 4 : 0)], 1u);
                __syncthreads();
                const int job = __builtin_amdgcn_readfirstlane((int)*sj);
                if (job >= NJ) break;
                int jj = job;
                if (jj < NJ_CUM) {
                {
                    const int bh = jj * 4 + wave, b = bh >> 2, hd = bh & 3;
                    const float fb = p.in[11][l * 4 + hd];
                    float vals[32]; float run = 0.f;
#pragma unroll
                    for (int i = 0; i < 32; ++i) {
                        const int t = lane * 32 + i;
                        const float xv = parts[(size_t)(b * S + t) * NINP + 1420 + hd] + fb;
                        const float ls = fminf(xv, 0.f) - log1pf(__expf(-fabsf(xv)));
                        run += ls; vals[i] = run;
                    }
                    float incl = run;
#pragma unroll
                    for (int o = 1; o < 64; o <<= 1) { const float v = __shfl_up(incl, o); if (lane >= o) incl += v; }
                    const float off = incl - run;
#pragma unroll
                    for (int i = 0; i < 32; ++i) cumb[(size_t)bh * S + lane * 32 + i] = off + vals[i];
                }
                    continue;
                }
                jj -= NJ_CUM;
                if (jj < NJ_MLA + NJ_CMP) {
                    const int seg = jj >> 8, off = jj & 255;
                    jj = (seg & 1) ? NJ_MLA + (seg >> 1) * 256 + off : (seg >> 1) * 256 + off;
                }
                if (jj < NJ_MLA) {
                    const bool doq = jj < (M / 64);
                    const int tok0 = (jj & (M / 64 - 1)) * 64, b = tok0 / S, t0 = tok0 % S;
                    bf16_t* aq = (bf16_t*)smem;
                    bf16_t* akv = aq + 64 * 264;
                    float* kr = (float*)(akv + 64 * 136);
                    float* krss = kr + 64 * 32;
                    float* rkk = krss + 64;
                    if (doq) {
                        const f32x4 g = *(const f32x4*)(p.in[12] + l * 256 + lane * 4);
#pragma unroll 1
                        for (int rb = wave * 16; rb < wave * 16 + 16; rb += 8) {
                            f32x4 v[8];
#pragma unroll
                            for (int k = 0; k < 8; ++k) v[k] = *(const f32x4*)(parts + (size_t)(tok0 + rb + k) * NINP + 1424 + lane * 4);
#pragma unroll
                            for (int k = 0; k < 8; ++k) {
                                const float ss = wsum(v[k][0] * v[k][0] + v[k][1] * v[k][1] + v[k][2] * v[k][2] + v[k][3] * v[k][3]);
                                const float rstd = rsqrtf(ss * (1.f / 256.f) + EPS);
                                *(u32x2*)(aq + (rb + k) * 264 + lane * 4) = (u32x2){pk2(v[k][0] * rstd * g[0], v[k][1] * rstd * g[1]), pk2(v[k][2] * rstd * g[2], v[k][3] * rstd * g[3])};
                            }
                        }
                    } else {
                        const f32x2 g2 = *(const f32x2*)(p.in[13] + l * 128 + lane * 2);
#pragma unroll 1
                        for (int rb = wave * 16; rb < wave * 16 + 16; rb += 8) {
                            f32x2 w[8]; float kvv[8];
#pragma unroll
                            for (int k = 0; k < 8; ++k) {
                                const float* pr = parts + (size_t)(tok0 + rb + k) * NINP;
                                w[k] = *(const f32x2*)(pr + 1680 + lane * 2);
                                kvv[k] = (lane < 32) ? pr[1808 + lane] : 0.f;
                            }
#pragma unroll
                            for (int k = 0; k < 8; ++k) {
                                const int r = rb + k;
                                const float ss = wsum(w[k][0] * w[k][0] + w[k][1] * w[k][1]);
                                const float rstd = rsqrtf(ss * (1.f / 128.f) + EPS);
                                *(unsigned*)(akv + r * 136 + lane * 2) = pk2(w[k][0] * rstd * g2[0], w[k][1] * rstd * g2[1]);
                                if (lane < 32) kr[r * 32 + lane] = kvv[k];
                                const float s2 = wsum(kvv[k] * kvv[k]);
                                if (lane == 0) krss[r] = s2;
                            }
                        }
                    }
                    __syncthreads();
                    const float* gq = p.in[16] + (size_t)l * 192;
                    const float* gk = gq + 96;
                    if (doq) {
#pragma unroll 1
                        for (int mt = 0; mt < 2; ++mt) {
                            f32x16 acc[3];
#pragma unroll
                            for (int c = 0; c < 3; ++c)
#pragma unroll
                                for (int i = 0; i < 16; ++i) acc[c][i] = 0.f;
#pragma unroll 8
                            for (int ks = 0; ks < 16; ++ks) {
                                const bf16x8 a0 = *(const bf16x8*)(aq + (mt * 32 + r32) * 264 + ks * 16 + hh * 8);
#pragma unroll
                                for (int nt = 0; nt < 3; ++nt) {
                                    const bf16x8 bb = *(const bf16x8*)(w_uq_t + (size_t)(wave * 96 + nt * 32 + r32) * 256 + ks * 16 + hh * 8);
                                    acc[nt] = MFMA32(a0, bb, acc[nt]);
                                }
                            }
                            const float gq0 = gq[r32], gq1 = gq[32 + r32], gq2 = gq[64 + r32];
#pragma unroll
                            for (int i = 0; i < 16; ++i) {
                                float ss = acc[0][i] * acc[0][i] + acc[1][i] * acc[1][i] + acc[2][i] * acc[2][i];
                                ss = sum32(ss);
                                const float rstd = rsqrtf(ss * (1.f / 96.f) + EPS);
                                const int row = mt * 32 + crow(i, hh), tok = tok0 + row;
                                float y0 = acc[0][i] * rstd * gq0;
                                const float y1 = acc[1][i] * rstd * gq1, y2 = acc[2][i] * rstd * gq2;
                                const float partner = __shfl_xor(y0, 16);
                                const f32x2 cs = rope[(size_t)tok * 28 + 8 + (r32 & 15)];
                                y0 = (r32 < 16) ? (y0 * cs[0] - partner * cs[1]) : (y0 * cs[0] + partner * cs[1]);
                                bf16_t* d = mq + (size_t)tok * 384 + wave * 96 + r32;
                                d[0] = f2bf(y0); d[32] = f2bf(y1); d[64] = f2bf(y2);
                                if ((i & 3) == 3) __builtin_amdgcn_sched_barrier(0);
                            }
                        }
                    }
                    if (!doq) {
#pragma unroll 1
                        for (int mt = 0; mt < 2; ++mt) {
                            f32x16 acc[4];
#pragma unroll
                            for (int c = 0; c < 4; ++c)
#pragma unroll
                                for (int i = 0; i < 16; ++i) acc[c][i] = 0.f;
#pragma unroll 8
                            for (int ks = 0; ks < 8; ++ks) {
                                const bf16x8 a0 = *(const bf16x8*)(akv + (mt * 32 + r32) * 136 + ks * 16 + hh * 8);
#pragma unroll
                                for (int nt = 0; nt < 4; ++nt) {
                                    const bf16x8 bb = *(const bf16x8*)(w_ukv_t + (size_t)(wave * 128 + nt * 32 + r32) * 128 + ks * 16 + hh * 8);
                                    acc[nt] = MFMA32(a0, bb, acc[nt]);
                                }
                            }
#pragma unroll
                            for (int i = 0; i < 16; ++i) {
                                const int row = mt * 32 + crow(i, hh), tok = tok0 + row;
                                float ss = acc[0][i] * acc[0][i] + acc[1][i] * acc[1][i];
                                ss = sum32(ss) + krss[row];
                                const float rstd = rsqrtf(ss * (1.f / 96.f) + EPS);
                                if (r32 == 0) rkk[row * 4 + wave] = rstd;
                                bf16_t* d = mk + (size_t)tok * 384 + wave * 96 + 32 + r32;
                                d[0] = f2bf(acc[0][i] * rstd * gk[32 + r32]);
                                d[32] = f2bf(acc[1][i] * rstd * gk[64 + r32]);
                            }
#pragma unroll
                            for (int nt = 2; nt < 4; ++nt)
#pragma unroll
                                for (int g = 0; g < 4; ++g) {
                                    const int dv = (nt - 2) * 32 + r32, tt = t0 + mt * 32 + 8 * g + 4 * hh;
                                    u32x2 w = {pk2(acc[nt][4 * g], acc[nt][4 * g + 1]), pk2(acc[nt][4 * g + 2], acc[nt][4 * g + 3])};
                                    *(u32x2*)(mvt + ((size_t)(b * 4 + wave) * 64 + dv) * S + tt) = w;
                                }
                        }
                    }
                    __syncthreads();
                    if (!doq)
                    for (int it = tid; it < 64 * 4 * 16; it += NT) {
                        const int row = it >> 6, hd = (it >> 4) & 3, j = it & 15, tok = tok0 + row;
                        const float rstd = rkk[row * 4 + hd];
                        const float x1 = kr[row * 32 + j] * rstd * gk[j], x2 = kr[row * 32 + 16 + j] * rstd * gk[16 + j];
                        const f32x2 cs = rope[(size_t)tok * 28 + 8 + j];
                        bf16_t* d = mk + (size_t)tok * 384 + hd * 96;
                        d[j] = f2bf(x1 * cs[0] - x2 * cs[1]);
                        d[16 + j] = f2bf(x2 * cs[0] + x1 * cs[1]);
                    }
                    __syncthreads();
                    continue;
                }
                jj -= NJ_MLA;
                if (jj < NJ_CMP) {
                    const int b = jj / 64, which = (jj / 32) & 1, c0 = (jj & 31) * 4;
                    float* B4 = (float*)smem;
                    float* red = B4 + 4 * 2048;
                    float* hid = red + 4 * 4 * 64;
                    const int colb = which ? 320 : 256;
                    const float* pe = p.in[7] + ((size_t)l * 2 + which) * 2048;
                    const float* w1 = p.in[8] + ((size_t)l * 2 + which) * 2048 * 64;
                    const float* w2 = p.in[9] + ((size_t)l * 2 + which) * 64 * 64;
#pragma unroll 1
                    for (int i0 = 0; i0 < 4 * 2048; i0 += 8 * NT) {
                        float xv[8], pv[8];
#pragma unroll
                        for (int k = 0; k < 8; ++k) {
                            const int i = i0 + k * NT + tid, ci = i >> 11, ii = i & 2047, pos = ii >> 6, d = ii & 63, t = (c0 + ci) * 16 + pos;
                            xv[k] = (t < S) ? parts[(size_t)(b * S + t) * NINP + colb + d] : 0.f; pv[k] = pe[ii];
                        }
#pragma unroll
                        for (int k = 0; k < 8; ++k) B4[i0 + k * NT + tid] = xv[k] + pv[k];
                    }
                    __syncthreads();
                    {
                        float a0 = 0.f, a1 = 0.f, a2 = 0.f, a3 = 0.f;
                        const float* wp = w1 + (size_t)(wave * 512) * 64 + lane;
                        const float* bp = B4 + wave * 512;
#pragma unroll 8
                        for (int i4 = 0; i4 < 128; ++i4) {
                            const f32x4 x0 = *(const f32x4*)(bp + i4 * 4), x1 = *(const f32x4*)(bp + 2048 + i4 * 4);
                            const f32x4 x2 = *(const f32x4*)(bp + 4096 + i4 * 4), x3 = *(const f32x4*)(bp + 6144 + i4 * 4);
#pragma unroll
                            for (int e = 0; e < 4; ++e) {
                                const float wv = wp[(size_t)(i4 * 4 + e) * 64];
                                a0 = fmaf(x0[e], wv, a0); a1 = fmaf(x1[e], wv, a1); a2 = fmaf(x2[e], wv, a2); a3 = fmaf(x3[e], wv, a3);
                            }
                        }
                        red[(wave * 4 + 0) * 64 + lane] = a0; red[(wave * 4 + 1) * 64 + lane] = a1;
                        red[(wave * 4 + 2) * 64 + lane] = a2; red[(wave * 4 + 3) * 64 + lane] = a3;
                    }
                    __syncthreads();
                    {
                        const int ci = wave, j = lane, c = c0 + ci;
                        const float hsum = red[(0 * 4 + ci) * 64 + j] + red[(1 * 4 + ci) * 64 + j] + red[(2 * 4 + ci) * 64 + j] + red[(3 * 4 + ci) * 64 + j];
                        hid[ci * 64 + j] = siluf_(hsum);
                        __syncthreads();
                        float o = 0.f;
#pragma unroll 16
                        for (int i = 0; i < 64; ++i) o += hid[ci * 64 + i] * w2[i * 64 + j];
                        if (which == 0) {
                            const float ss = wsum(o * o);
                            o = o * rsqrtf(ss * (1.f / 64.f) + EPS) * p.in[6][(size_t)l * 256 + 64 + j];
                        }
                        if (c < 127) (which ? vcmp : kcmp)[((size_t)b * 128 + c) * 64 + j] = o;
                    }
                    __syncthreads();
                    continue;
                }
                jj -= NJ_CMP;
                if (jj < 1024) {
                    const int seg = jj >> 8, off = jj & 255;
                    jj = (seg & 1) ? NJ_TC + (seg >> 1) * 256 + off : (seg >> 1) * 256 + off;
                } else jj -= 512;
                if (jj < NJ_TC) {
                    const int ct = jj / (M / 256), tt4 = jj % (M / 256);
                    const int tok0 = tt4 * 256, b = tok0 / S, t0 = tok0 % S;
                    int col; bf16_t* dst;
                    if (ct == 0) { col = 448; dst = vts + (size_t)b * 64 * S; }
                    else if (ct == 1) { col = 576; dst = vtw + (size_t)b * 64 * S; }
                    else if (ct < 6) { col = 1164 + (ct - 2) * 64; dst = fvt + (size_t)(b * 4 + ct - 2) * 64 * S; }
                    else { col = 2352 + (ct - 6) * 64; dst = dvt + (size_t)(b * 4 + ct - 6) * 64 * S; }
#pragma unroll 1
                    for (int k4 = 0; k4 < 4; ++k4) tc_tile(parts + (size_t)b * S * NINP, NINP, NINP, t0 + k4 * 64, col, dst, S, 0, (float*)smem, tid);
                    continue;
                }
                jj -= NJ_TC;
                if (jj < NJ_TOK) {
#pragma unroll 1
                    for (int ti = 0; ti < 8; ++ti) {
                    const int tok = jj * 32 + wave * 8 + ti;
                    const float* pr = parts + (size_t)tok * NINP;
                    const f32x2* rt = rope + (size_t)tok * 28;
                    const float* ng = p.in[6] + (size_t)l * 256;
                    float vq[4], vfq[4], vfk[4], vdq[4], vdk[4];
#pragma unroll
                    for (int hd = 0; hd < 4; ++hd) {
                        vq[hd] = pr[hd * 64 + lane]; vfq[hd] = pr[652 + hd * 64 + lane]; vfk[hd] = pr[908 + hd * 64 + lane];
                        vdq[hd] = pr[1840 + hd * 64 + lane]; vdk[hd] = pr[2096 + hd * 64 + lane];
                    }
                    const float vks = pr[384 + lane], vkw = pr[512 + lane], vg = (lane < 12) ? pr[640 + lane] : 0.f;
#pragma unroll
                    for (int hd = 0; hd < 4; ++hd) {
                        const float y = norm_rope<64>(vq[hd], ng, rt, 16, 0, lane);
                        qnsa[(size_t)tok * 256 + hd * 64 + lane] = f2bf(y);
                        qfnsa[(size_t)tok * 256 + hd * 64 + lane] = y;
                    }
                    ksb[(size_t)tok * 64 + lane] = f2bf(norm_rope<64>(vks, ng + 128, rt, 16, 0, lane));
                    kwb[(size_t)tok * 64 + lane] = f2bf(norm_rope<64>(vkw, ng + 192, rt, 16, 0, lane));
                    if (lane < 12) gn[(size_t)tok * 12 + lane] = sigmoidf_(vg);
                    const float* fg = p.in[10] + (size_t)l * 128;
#pragma unroll
                    for (int hd = 0; hd < 4; ++hd) {
                        fq[(size_t)tok * 256 + hd * 64 + lane] = f2bf(norm_rope<64>(vfq[hd], fg, rt, 0, 0, lane));
                        fk[(size_t)tok * 256 + hd * 64 + lane] = f2bf(norm_rope<64>(vfk[hd], fg + 64, rt, 0, 0, lane));
                    }
                    const float* dg = p.in[17] + (size_t)l * 64;
#pragma unroll
                    for (int hd = 0; hd < 4; ++hd) {
                        dq[(size_t)tok * 256 + hd * 64 + lane] = f2bf(norm_rope<32>(vdq[hd], dg, rt, 8, 24, lane));
                        dkb[(size_t)tok * 256 + hd * 64 + lane] = f2bf(norm_rope<32>(vdk[hd], dg + 32, rt, 8, 24, lane));
                    }
                    }
                    continue;
                }
            }
        } else if (sub == 3 && EN(4)) {
            const int NJ_C = M / 32;
            const int ntn = 4096 / 128;
            const int nrc = (NJ_C + (int)gridDim.x - 1) / (int)gridDim.x;
            for (int kk = 0;; ++kk) {
                const int job = (kk < nrc) ? (int)blockIdx.x + kk * (int)gridDim.x : NJ_C;
                if (kk < nrc && job >= NJ_C) continue;
                if (job < NJ_C) {
                    const int tokb = job * 32, b = tokb / S;
                    float* P = (float*)smem;
                    {
                        f32x4 k0[16], k1[16];
                        const f32x4* kp0 = (const f32x4*)(kcmp + ((size_t)b * 128 + lane) * 64);
                        const f32x4* kp1 = (const f32x4*)(kcmp + ((size_t)b * 128 + (lane < 63 ? lane + 64 : 126)) * 64);
#pragma unroll
                        for (int i = 0; i < 16; ++i) { k0[i] = kp0[i]; k1[i] = kp1[i]; }
#pragma unroll 1
                        for (int ti = 0; ti < 8; ++ti) {
                            const int tok = tokb + wave * 8 + ti, t = tok % S;
                            const int nvis = (t >= 31) ? ((t - 31) / 16 + 1) : 0;
                            const bool v0 = lane < nvis, v1 = (lane + 64) < nvis;
                            float imp = 0.f;
#pragma unroll
                            for (int hd = 0; hd < 4; ++hd) {
                                const float qv = qfnsa[(size_t)tok * 256 + hd * 64 + lane];
                                float s0 = 0.f, s1 = 0.f;
#pragma unroll
                                for (int d = 0; d < 64; ++d) {
                                    const float qd = __builtin_bit_cast(float, __builtin_amdgcn_readlane(__builtin_bit_cast(int, qv), d));
                                    s0 = fmaf(qd, k0[d >> 2][d & 3], s0); s1 = fmaf(qd, k1[d >> 2][d & 3], s1);
                                }
                                s0 = v0 ? s0 * 0.125f : -1e30f; s1 = v1 ? s1 * 0.125f : -1e30f;
                                const float mx = wmax(fmaxf(s0, s1));
                                const float e0 = v0 ? __expf(s0 - mx) : 0.f, e1 = v1 ? __expf(s1 - mx) : 0.f;
                                const float sm_ = wsum(e0 + e1);
                                const float inv = (nvis > 0) ? 1.f / sm_ : 0.f;
                                float* pr_ = P + (wave * 32 + ti * 4 + hd) * 128;
                                pr_[lane] = e0 * inv; pr_[lane + 64] = e1 * inv;
                            }
                            __syncthreads();
                            if (lane < 32) {
#pragma unroll
                                for (int hd = 0; hd < 4; ++hd) {
                                    const float* pr_ = P + (wave * 32 + ti * 4 + hd) * 128;
#pragma unroll
                                    for (int dc = -1; dc <= 3; ++dc) { const int c = 4 * lane + dc; if (c >= 0 && c <= 126) imp += pr_[c]; }
                                }
                            }
                            const int cur = t >> 6, j = lane;
                            float score;
                            if (j * 64 > t) score = -1.f;
                            else if (j == 0 || j == cur || j == cur - 1) score = 1e4f;
                            else score = imp;
                            if (j >= 32) score = -2.f;
                            int cnt = 0;
#pragma unroll
                            for (int i = 0; i < 32; ++i) {
                                const float si = __builtin_bit_cast(float, __builtin_amdgcn_readlane(__builtin_bit_cast(int, score), i));
                                cnt += (si > score || (si == score && i < j)) ? 1 : 0;
                            }
                            const bool sel = (j < 32) && (cnt < 16) && (j * 64 <= t);
                            const unsigned long long bal = __ballot(sel);
                            if (lane == 0) selm[tok] = (unsigned)bal;
                        }
                    }
                    __syncthreads();
                    {
                        float vcol[128];
#pragma unroll
                        for (int c = 0; c < 127; ++c) vcol[c] = vcmp[((size_t)b * 128 + c) * 64 + lane];
                        vcol[127] = 0.f;
#pragma unroll 1
                        for (int pi = 0; pi < 32; ++pi) {
                            const f32x4* pr_ = (const f32x4*)(P + (wave * 32 + pi) * 128);
                            float o0 = 0.f, o1 = 0.f;
#pragma unroll
                            for (int c4 = 0; c4 < 32; ++c4) {
                                const f32x4 pv = pr_[c4];
                                o0 = fmaf(pv[0], vcol[4 * c4], o0); o1 = fmaf(pv[1], vcol[4 * c4 + 1], o1);
                                o0 = fmaf(pv[2], vcol[4 * c4 + 2], o0); o1 = fmaf(pv[3], vcol[4 * c4 + 3], o1);
                            }
                            const int tok = tokb + wave * 8 + (pi >> 2), hd = pi & 3;
                            ocmp[(size_t)tok * 256 + hd * 64 + lane] = o0 + o1;
                        }
                    }
                    __syncthreads();
                } else break;
            }
        } else if (sub == 4 && EN(5)) {
            unsigned* su = (unsigned*)(smem + LDS_BYTES - 16);
            const float lam_init = __builtin_bit_cast(float, __builtin_amdgcn_readfirstlane(__builtin_bit_cast(int, 0.8f - 0.6f * expf(-0.3f * (float)l))));
            const float one_m_lam = __builtin_bit_cast(float, __builtin_amdgcn_readfirstlane(__builtin_bit_cast(int, 1.f - lam_init)));
            float lam;
            {
                const float* lv = p.in[18] + (size_t)l * 128;
                const int j = lane & 31;
                const float a1 = sum32(lv[j] * lv[32 + j]), a2 = sum32(lv[64 + j] * lv[96 + j]);
                lam = expf(a1) - expf(a2) + lam_init;
                lam = __builtin_bit_cast(float, __builtin_amdgcn_readfirstlane(__builtin_bit_cast(int, lam)));
            }
            const int role = (blockIdx.x >= (gridDim.x >> 1)) ? 1 : 0;
#pragma unroll 1
            for (int step = 0; step < 3; ++step) {
            const int what = role ? (step == 0 ? 2 : (step == 1 ? 1 : 0)) : (step == 0 ? 0 : (step == 1 ? 2 : 1));
            if (what == 2) {
            {
                const int ntn = 4096 / 128;
                for (int k = 0;; ++k) {
                    int tm, tn; if (!xcd_unit(k, 16, ntn, tm, tn)) break;
                    f32x16 acc[2][2]; zero_acc(acc);
                    gemm_main<2>(w_g_t, D, RowPlain{tn * 128}, hbuf, D, tm * 128, D / 64, acc, smem, NoHook{}, tid);
                    const int colb = tn * 128 + wr * 64 + 4 * hh, rowb = tm * 128 + wc * 64 + r32;
                    const float* gb = p.in[22] + (size_t)l * 4096 + colb;
                    bf16_t* gub = gates + (size_t)rowb * GLD + colb;
#pragma unroll
                    for (int mt = 0; mt < 2; ++mt)
#pragma unroll
                        for (int g = 0; g < 4; ++g) {
                            const f32x4 bv = *(const f32x4*)(gb + mt * 32 + 8 * g);
#pragma unroll
                            for (int nt = 0; nt < 2; ++nt) {
                                const float s0 = sigmoidf_(acc[mt][nt][4 * g + 0] + bv[0]), s1 = sigmoidf_(acc[mt][nt][4 * g + 1] + bv[1]);
                                const float s2 = sigmoidf_(acc[mt][nt][4 * g + 2] + bv[2]), s3 = sigmoidf_(acc[mt][nt][4 * g + 3] + bv[3]);
                                *(u32x2*)(gub + (size_t)(nt * 32) * GLD + mt * 32 + 8 * g) = (u32x2){pk2(s0, s1), pk2(s2, s3)};
                            }
                        }
                }
            }
            } else for (;;) {
                if (tid == 0) *su = atomicAdd(&ctr[l + 8 * what], 1u);
                __syncthreads();
                const unsigned u = (unsigned)__builtin_amdgcn_readfirstlane((int)*su);
                __syncthreads();
                if (u >= 1024u) break;
                const unsigned uu = 2u * u + (unsigned)what;
                const int qb = 15 - (int)(uu >> 7), rem = uu & 127, type = rem >> 5, bh = rem & 31, b = bh >> 2, hd = bh & 3;
                const int q0 = qb * 128;
                const bf16_t *Qa, *Ka, *Va, *Qb2, *Kb2, *Vb2; int qs, ksr, nks, mode0, mode1, npass; float scale; const float* cu = nullptr;
                if (type == 0) {
                    Qa = Qb2 = qnsa + (size_t)b * S * 256 + hd * 64; qs = 256; ksr = 64; nks = 4; scale = 0.125f; npass = 2; mode0 = 2; mode1 = 3;
                    Ka = ksb + (size_t)b * S * 64; Kb2 = kwb + (size_t)b * S * 64; Va = vts + (size_t)b * 64 * S; Vb2 = vtw + (size_t)b * 64 * S;
                } else if (type == 1) {
                    Qa = Qb2 = fq + (size_t)b * S * 256 + hd * 64; Ka = Kb2 = fk + (size_t)b * S * 256 + hd * 64; Va = Vb2 = fvt + (size_t)bh * 64 * S;
                    qs = 256; ksr = 256; nks = 4; scale = 0.125f; npass = 1; mode0 = mode1 = 1; cu = cumb + (size_t)bh * S;
                } else if (type == 2) {
                    Qa = Qb2 = mq + (size_t)b * S * 384 + hd * 96; Ka = Kb2 = mk + (size_t)b * S * 384 + hd * 96; Va = Vb2 = mvt + (size_t)bh * 64 * S;
                    qs = 384; ksr = 384; nks = 6; scale = 0.10206207261596577f; npass = 1; mode0 = mode1 = 0;
                } else {
                    Qa = dq + (size_t)b * S * 256 + hd * 64; Qb2 = Qa + 32; Ka = dkb + (size_t)b * S * 256 + hd * 64; Kb2 = Ka + 32; Va = Vb2 = dvt + (size_t)bh * 64 * S;
                    qs = 256; ksr = 256; nks = 2; scale = 0.17677669529663687f; npass = 2; mode0 = mode1 = 0;
                }
                f32x16 O[2];
#pragma nounroll
                for (int pass = 0; pass < npass; ++pass) {
                    attn_pass(pass ? Qb2 : Qa, qs, pass ? Kb2 : Ka, ksr, pass ? Vb2 : Va, cu, selm + (size_t)b * S, scale, nks, pass ? mode1 : mode0, q0, O, smem, wave, lane, tid);
                    if (npass == 2 && pass == 0) {
                        const size_t tok = (size_t)b * S + q0 + wave * 32 + r32;
                        float* tp = ((type == 0) ? ntmp : dtmp) + tok * 256 + hd * 64 + 4 * hh;
                        const float* ocp = ocmp + tok * 256 + hd * 64 + 4 * hh;
                        float g0 = 0.f, g1 = 0.f;
                        if (type == 0) { g0 = gn[tok * 12 + hd]; g1 = gn[tok * 12 + 4 + hd]; }
#pragma unroll
                        for (int dvb = 0; dvb < 2; ++dvb)
#pragma unroll
                            for (int g = 0; g < 4; ++g) {
                                f32x4 v = {O[dvb][4 * g], O[dvb][4 * g + 1], O[dvb][4 * g + 2], O[dvb][4 * g + 3]};
                                f32x4* a = (f32x4*)(tp + dvb * 32 + 8 * g);
                                if (type == 0) { const f32x4 oc = *(const f32x4*)(ocp + dvb * 32 + 8 * g); v = oc * g0 + v * g1; }
                                *a = v;
                            }
                    }
                }
                const int cbase = type * 256;
                const size_t tok = (size_t)b * S + q0 + wave * 32 + r32;
                const float* tp = ((type == 0) ? ntmp : dtmp) + tok * 256 + hd * 64 + 4 * hh;
                if (type == 0) {
                    const float g2 = gn[tok * 12 + 8 + hd];
#pragma unroll
                    for (int dvb = 0; dvb < 2; ++dvb)
#pragma unroll
                        for (int g = 0; g < 4; ++g) {
                            const f32x4 oc = *(const f32x4*)(tp + dvb * 32 + 8 * g);
#pragma unroll
                            for (int e = 0; e < 4; ++e) O[dvb][4 * g + e] = oc[e] + g2 * O[dvb][4 * g + e];
                        }
                } else if (type == 3) {
                    float ss = 0.f;
#pragma unroll
                    for (int dvb = 0; dvb < 2; ++dvb)
#pragma unroll
                        for (int g = 0; g < 4; ++g) {
                            const f32x4 oc = *(const f32x4*)(tp + dvb * 32 + 8 * g);
#pragma unroll
                            for (int e = 0; e < 4; ++e) { const float r = oc[e] - lam * O[dvb][4 * g + e]; O[dvb][4 * g + e] = r; ss += r * r; }
                        }
                    ss += __shfl_xor(ss, 32);
                    const float rstd = rsqrtf(ss * (1.f / 64.f) + EPS);
                    const float* og = p.in[19] + (size_t)l * 64;
#pragma unroll
                    for (int dvb = 0; dvb < 2; ++dvb)
#pragma unroll
                        for (int g = 0; g < 4; ++g) {
                            const f32x4 gg = *(const f32x4*)(og + dvb * 32 + 8 * g + 4 * hh);
#pragma unroll
                            for (int e = 0; e < 4; ++e) O[dvb][4 * g + e] *= rstd * (gg[e] * one_m_lam);
                        }
                }
                store_o(obuf + tok * 1024 + cbase + hd * 64, O, hh);
            }
            }
        } else if (sub == 5 && EN(6)) {
            const int ntn = D / 128;
            for (int k = 0;; ++k) {
                int tm, tn; if (!xcd_unit(k, 16, ntn, tm, tn)) break;
                f32x16 acc[2][2], mg[2][2]; zero_acc(acc); zero_acc(mg);
                const int colb = tn * 128 + wr * 64 + 4 * hh, rowb = tm * 128 + wc * 64 + r32;
                const bf16_t* gub = gates + (size_t)rowb * GLD + colb;
                auto hook = [&](int kt, f32x16 (&a)[2][2]) {
                    if ((kt & 3) == 3) {
                        const bf16_t* gu = gub + (kt >> 2) * 1024;
#pragma unroll
                        for (int mt = 0; mt < 2; ++mt)
#pragma unroll
                            for (int nt = 0; nt < 2; ++nt)
#pragma unroll
                                for (int g = 0; g < 4; ++g) {
                                    const u32x2 gv = *(const u32x2*)(gu + (size_t)(nt * 32) * GLD + mt * 32 + 8 * g);
                                    mg[mt][nt][4 * g + 0] += __uint_as_float(gv[0] << 16) * a[mt][nt][4 * g + 0];
                                    mg[mt][nt][4 * g + 1] += __uint_as_float(gv[0] & 0xffff0000u) * a[mt][nt][4 * g + 1];
                                    mg[mt][nt][4 * g + 2] += __uint_as_float(gv[1] << 16) * a[mt][nt][4 * g + 2];
                                    mg[mt][nt][4 * g + 3] += __uint_as_float(gv[1] & 0xffff0000u) * a[mt][nt][4 * g + 3];
                                    a[mt][nt][4 * g + 0] = 0.f; a[mt][nt][4 * g + 1] = 0.f; a[mt][nt][4 * g + 2] = 0.f; a[mt][nt][4 * g + 3] = 0.f;
                                }
                    }
                };
                gemm_main1<2>(w_br_t, D, RowPlain{tn * 128}, obuf, D, tm * 128, D / 64, acc, smem, hook, tid);
                bf16_t* hub = hbuf + (size_t)rowb * D + colb;
#pragma unroll
                for (int mt = 0; mt < 2; ++mt)
#pragma unroll
                    for (int nt = 0; nt < 2; ++nt)
#pragma unroll
                        for (int g = 0; g < 4; ++g) {
                            u32x2 w = {pk2(mg[mt][nt][4 * g], mg[mt][nt][4 * g + 1]), pk2(mg[mt][nt][4 * g + 2], mg[mt][nt][4 * g + 3])};
                            *(u32x2*)(hub + (size_t)(nt * 32) * D + mt * 32 + 8 * g) = w;
                        }
            }
        } else if ((sub == 6 || sub == 9) && EN(7)) {
            const int ntn = D / 128;
            const bf16_t* A = (sub == 6) ? hbuf : abuf;
            const int lda = (sub == 6) ? D : DFF;
            const bf16_t* Bt = (sub == 6) ? w_o_t : w_dn_t;
            const float* xs = (sub == 6) ? xcur : xo;
            const int og = (sub == 6) ? 2048 : 5120;
            for (int k = 0;; ++k) {
                int tm, tn; if (!xcd_unit(k, 16, ntn, tm, tn)) break;
                f32x16 acc[2][2]; zero_acc(acc);
                gemm_main<2>(A, lda, RowPlain{tm * 128}, Bt, lda, tn * 128, lda / 64, acc, smem, NoHook{}, tid);
                const float* mb = modl + (size_t)(tm * 128 / S) * 6144 + og;
#pragma unroll
                for (int mt = 0; mt < 2; ++mt)
#pragma unroll
                    for (int nt = 0; nt < 2; ++nt)
#pragma unroll
                        for (int i = 0; i < 16; ++i) {
                            const int row = tm * 128 + wr * 64 + mt * 32 + crow(i, hh), col = tn * 128 + wc * 64 + nt * 32 + r32;
                            xo[(size_t)row * D + col] = xs[(size_t)row * D + col] + mb[col] * acc[mt][nt][i];
                        }
            }
        } else if (sub == 8 && EN(8)) {
            const int ntn = 44, ntm = 17;
            const float* cw = p.in[25] + (size_t)l * 3 * DFF;
            const float* cb = p.in[26] + (size_t)l * DFF;
            float* gl = (float*)smem;
            for (int k = 0;; ++k) {
                int tmg, tn; if (!xcd_unit(k, ntm, ntn, tmg, tn)) break;
                const int b = tmg / ntm, tmm = tmg - b * ntm;
                const int t0 = tmm * 126 - 2;
                f32x16 acc[2][2]; zero_acc(acc);
                gemm_main<2>(hbuf, D, RowClamp{b * S, t0}, w_up_t, D, tn * 128, D / 64, acc, smem, NoHook{}, tid);
                {
                    float* wl = gl + (wr * 64 + 4 * hh) * 129 + wc * 64 + r32;
#pragma unroll
                    for (int mt = 0; mt < 2; ++mt)
#pragma unroll
                        for (int nt = 0; nt < 2; ++nt)
#pragma unroll
                            for (int i = 0; i < 16; ++i) wl[(mt * 32 + (i & 3) + 8 * (i >> 2)) * 129 + nt * 32] = acc[mt][nt][i];
                }
                __syncthreads();
                {
                    const int cc = tid & 63, rs = (tid >> 6) * 32, ch = tn * 64 + cc;
                    const float w0 = cw[ch], w1 = cw[DFF + ch], w2 = cw[2 * DFF + ch], bb = cb[ch];
                    float ga = 0.f, gb2 = 0.f;
                    if (rs >= 2) { ga = gl[(rs - 2) * 129 + cc]; gb2 = gl[(rs - 1) * 129 + cc]; }
                    bf16_t* ap = abuf + ((ptrdiff_t)(b * S + t0 + rs)) * DFF + ch;
#pragma unroll 4
                    for (int k = 0; k < 32; ++k) {
                        const int r = rs + k, t = t0 + r;
                        float gc = gl[r * 129 + cc];
                        if (t < 0) gc = 0.f;
                        const float vv = gl[r * 129 + 64 + cc];
                        if (r >= 2 && t < S) ap[(ptrdiff_t)k * DFF] = f2bf(siluf_(w0 * ga + w1 * gb2 + w2 * gc + bb) * vv);
                        ga = gb2; gb2 = gc;
                    }
                }
                __syncthreads();
            }
        }
        if (PROBE_SUB >= 0 || PROBE_MASK != 0u) { if ((sub == PROBE_SUB || ((PROBE_MASK >> sub) & 1u)) && !probe_second) { probe_second = true; --ph; } else probe_second = false; }
    }
}

extern "C" void kernel_launch(void* const* d_in, const int* in_sizes, int n_in, void* d_out, int out_size, void* d_ws, size_t ws_size, hipStream_t stream) {
    static int grid = 0;
    if (grid == 0) {
        if (n_in != 28 || ws_size < WS_END) { fprintf(stderr, "kernel_launch: bad inputs n_in %d ws %zu need %zu\n", n_in, ws_size, (size_t)WS_END); grid = -1; return; }
        int dev = 0, cus = 0, per_cu = 0;
        hipGetDevice(&dev);
        hipDeviceGetAttribute(&cus, hipDeviceAttributeMultiprocessorCount, dev);
        if (hipFuncSetAttribute((const void*)mega, hipFuncAttributeMaxDynamicSharedMemorySize, LDS_BYTES) != hipSuccess) { fprintf(stderr, "hipFuncSetAttribute failed\n"); grid = -1; return; }
        if (hipOccupancyMaxActiveBlocksPerMultiprocessor(&per_cu, (const void*)mega, NT, LDS_BYTES) != hipSuccess || per_cu < 1) { fprintf(stderr, "occupancy query failed\n"); per_cu = 1; }
        if (per_cu > 2) per_cu = 2;
        grid = cus * per_cu;
    }
    if (grid < 0) return;
    if (hipMemsetAsync((char*)d_ws + WS_CTR, 0, 256, stream) != hipSuccess) { fprintf(stderr, "memset failed\n"); return; }
    if (hipMemsetAsync((char*)d_ws + WS_BAR, 0, 16384, stream) != hipSuccess) { fprintf(stderr, "memset failed\n"); return; }
    Params p{};
    for (int i = 0; i < 28; ++i) p.in[i] = (const float*)d_in[i];
    p.out = (float*)d_out; p.ws = (unsigned char*)d_ws; p.ph_lo = 0; p.ph_hi = 1 + NL * 10;
    void* args[] = {&p};
    hipError_t e = hipLaunchCooperativeKernel((const void*)mega, dim3(grid), dim3(NT), args, LDS_BYTES, stream);
    if (e != hipSuccess) fprintf(stderr, "cooperative launch failed: %s (grid %d)\n", hipGetErrorString(e), grid);
}
```

```cpp
#include <hip/hip_runtime.h>
#include <hip/hip_cooperative_groups.h>
#include <stdint.h>
#include <stdio.h>
#include <math.h>
namespace cg = cooperative_groups;

typedef unsigned short bf16_t;
typedef short bf16x8 __attribute__((ext_vector_type(8)));
typedef short s16x4 __attribute__((ext_vector_type(4)));
typedef float f32x16 __attribute__((ext_vector_type(16)));
typedef float f32x4 __attribute__((ext_vector_type(4)));
typedef float f32x2 __attribute__((ext_vector_type(2)));
typedef unsigned u32x4 __attribute__((ext_vector_type(4)));
typedef unsigned u32x2 __attribute__((ext_vector_type(2)));
typedef __bf16 bfv2 __attribute__((ext_vector_type(2)));

#define DI __device__ __forceinline__
#define MFMA32(a, b, c) __builtin_amdgcn_mfma_f32_32x32x16_bf16((a), (b), (c), 0, 0, 0)

constexpr int NB = 8, S = 2048, D = 1024, M = NB * S, NL = 4;
constexpr int NIN = 2608, NINP = 2688, DFF = 2816;
constexpr float EPS = 1e-6f;
constexpr int NT = 256;

constexpr size_t al256(size_t x) { return (x + 255) & ~(size_t)255; }
constexpr size_t WS_CTR = 0;
constexpr size_t WS_MOD = 256;
constexpr size_t WS_ROPE = al256(WS_MOD + (size_t)NL * NB * 6144 * 4);
constexpr size_t WS_W = al256(WS_ROPE + (size_t)M * 28 * 8);
constexpr size_t W_IN = 0;
constexpr size_t W_G = W_IN + (size_t)NINP * 1024 * 2;
constexpr size_t W_BR = W_G + (size_t)4096 * 1024 * 2;
constexpr size_t W_O = W_BR + (size_t)1024 * 1024 * 2;
constexpr size_t W_UP = W_O + (size_t)1024 * 1024 * 2;
constexpr size_t W_DN = W_UP + (size_t)5632 * 1024 * 2;
constexpr size_t W_UQ = W_DN + (size_t)1024 * 2816 * 2;
constexpr size_t W_UKV = W_UQ + (size_t)384 * 256 * 2;
constexpr size_t W_END = W_UKV + (size_t)512 * 128 * 2;
constexpr size_t WS_H = al256(WS_W + W_END);
constexpr size_t WS_R1 = al256(WS_H + (size_t)M * 1024 * 2);
constexpr size_t R1_GATES = 0;
constexpr int GLD = 4160;
constexpr size_t R1_OBUF = (size_t)M * GLD * 2;
constexpr size_t R1_ABUF = 0;
constexpr size_t WS_R2 = al256(WS_R1 + (size_t)M * NINP * 4);
constexpr size_t R2_QNSA = 0;
constexpr size_t R2_QFNSA = R2_QNSA + (size_t)M * 256 * 2;
constexpr size_t R2_KS = R2_QFNSA + (size_t)M * 256 * 4;
constexpr size_t R2_KW = R2_KS + (size_t)M * 64 * 2;
constexpr size_t R2_VTS = R2_KW + (size_t)M * 64 * 2;
constexpr size_t R2_VTW = R2_VTS + (size_t)M * 64 * 2;
constexpr size_t R2_GN = R2_VTW + (size_t)M * 64 * 2;
constexpr size_t R2_KCMP = R2_GN + (size_t)M * 12 * 4;
constexpr size_t R2_VCMP = R2_KCMP + (size_t)NB * 128 * 64 * 4;
constexpr size_t R2_OCMP = R2_VCMP + (size_t)NB * 128 * 64 * 4;
constexpr size_t R2_SELM = R2_OCMP + (size_t)M * 256 * 4;
constexpr size_t R2_FQ = R2_SELM + (size_t)M * 4;
constexpr size_t R2_FK = R2_FQ + (size_t)M * 256 * 2;
constexpr size_t R2_FVT = R2_FK + (size_t)M * 256 * 2;
constexpr size_t R2_CUM = R2_FVT + (size_t)M * 256 * 2;
constexpr size_t R2_MQ = R2_CUM + (size_t)NB * 4 * S * 4;
constexpr size_t R2_MK = R2_MQ + (size_t)M * 384 * 2;
constexpr size_t R2_MVT = R2_MK + (size_t)M * 384 * 2;
constexpr size_t R2_DQ = R2_MVT + (size_t)M * 256 * 2;
constexpr size_t R2_DK = R2_DQ + (size_t)M * 256 * 2;
constexpr size_t R2_DVT = R2_DK + (size_t)M * 256 * 2;
constexpr size_t R2_DTMP = R2_DVT + (size_t)M * 256 * 2;
constexpr size_t R2_NTMP = R2_DTMP + (size_t)M * 256 * 4;
constexpr size_t R2_END = R2_NTMP + (size_t)M * 256 * 4;
constexpr size_t WS_BAR = al256(WS_R2 + R2_END);
constexpr size_t WS_END = WS_BAR + 16384;

constexpr int LDS_BYTES = 73728;
#ifndef PROBE_SUB
#define PROBE_SUB (-1)
#endif
#ifndef PROBE_MASK
#define PROBE_MASK 0u
#endif
#ifndef EN_MASK
#define EN_MASK 0xffffu
#endif
#define EN(k) ((EN_MASK >> (k)) & 1u)
#ifndef TY_MASK
#define TY_MASK 0xfu
#endif
#define TY(k) ((TY_MASK >> (k)) & 1u)

struct Params {
    const float* in[28];
    float* out;
    unsigned char* ws;
    int ph_lo, ph_hi;
};

DI unsigned pk2(float a, float b) { f32x2 v = {a, b}; bfv2 r = __builtin_convertvector(v, bfv2); return __builtin_bit_cast(unsigned, r); }
DI bf16_t f2bf(float a) { return (bf16_t)(pk2(a, 0.f) & 0xffffu); }
DI float bf2f(bf16_t v) { return __uint_as_float(((unsigned)v) << 16); }
template <int CTRL> DI float dpp_f(float v) { return __builtin_bit_cast(float, __builtin_amdgcn_update_dpp(0, __builtin_bit_cast(int, v), CTRL, 0xf, 0xf, true)); }
DI float sum16_dpp(float v) {
    v += dpp_f<0xB1>(v);
    v += dpp_f<0x4E>(v);
    v += dpp_f<0x141>(v);
    v += dpp_f<0x140>(v);
    return v;
}
DI float wsum(float v) {
    v = sum16_dpp(v);
    v += __shfl_xor(v, 16);
    v += __shfl_xor(v, 32);
    return v;
}
DI float wmax(float v) {
#pragma unroll
    for (int o = 1; o < 64; o <<= 1) v = fmaxf(v, __shfl_xor(v, o));
    return v;
}
DI float sum32(float v) {
    v = sum16_dpp(v);
    v += __shfl_xor(v, 16);
    return v;
}
DI float sigmoidf_(float x) { return __builtin_amdgcn_rcpf(1.f + __builtin_amdgcn_exp2f(-1.4426950408889634f * x)); }
DI float siluf_(float x) { return x * __builtin_amdgcn_rcpf(1.f + __builtin_amdgcn_exp2f(-1.4426950408889634f * x)); }
DI int crow(int i, int hh) { return (i & 3) + 8 * (i >> 2) + 4 * hh; }

DI void tc_tile(const float* __restrict__ src, int ld, int nvalid, int k0, int n0, bf16_t* __restrict__ dst, int ldd, int drow0, float* sm, int tid) {
#pragma unroll
    for (int p = 0; p < 4; ++p) {
        const int r = p * 16 + (tid >> 4), c4 = (tid & 15) * 4;
        f32x4 v = {0.f, 0.f, 0.f, 0.f};
        if (n0 + c4 < nvalid) v = *(const f32x4*)(src + (size_t)(k0 + r) * ld + n0 + c4);
        sm[r * 65 + c4 + 0] = v[0]; sm[r * 65 + c4 + 1] = v[1]; sm[r * 65 + c4 + 2] = v[2]; sm[r * 65 + c4 + 3] = v[3];
    }
    __syncthreads();
    const int n = tid >> 2, ks = (tid & 3) * 16;
    unsigned w[8];
#pragma unroll
    for (int i = 0; i < 8; ++i) w[i] = pk2(sm[(ks + 2 * i) * 65 + n], sm[(ks + 2 * i + 1) * 65 + n]);
    u32x4* d = (u32x4*)(dst + (size_t)(drow0 + n) * ldd + k0 + ks);
    d[0] = (u32x4){w[0], w[1], w[2], w[3]};
    d[1] = (u32x4){w[4], w[5], w[6], w[7]};
    __syncthreads();
}

DI void tc_matrix(const float* src, int K, int N, bf16_t* dst, int ldd, float* sm, int mode  , int tid) {
    const int nkt = K / 64, nnt = (N + 63) / 64;
    for (int j = blockIdx.x; j < nkt * nnt; j += gridDim.x) {
        const int tn = j / nkt, tk = j % nkt;
        int drow0 = tn * 64;
        if (mode == 1) drow0 = (tn < 44) ? tn * 128 : (tn - 44) * 128 + 64;
        tc_tile(src, N, N, tk * 64, tn * 64, dst, ldd, drow0, sm, tid);
    }
}

struct NoHook { template <class T> DI void operator()(int, T&) const {} };

template <int NTW, class AR, class HK>
DI void gemm_main(const bf16_t* __restrict__ A, int lda, AR arow, const bf16_t* __restrict__ Bt, int ldb, int col0, int nk,
                  f32x16 (&acc)[2][NTW], unsigned char* smraw, HK hook, int tid) {
    constexpr int BROWS = 64 * NTW, NBL = 2 * NTW;
    bf16_t* sa = (bf16_t*)smraw;
    bf16_t* sb = sa + 2 * 128 * 72;
    const int lane = tid & 63, wave = __builtin_amdgcn_readfirstlane(tid >> 6), wr = wave >> 1, wc = wave & 1, r32 = lane & 31, hh = lane >> 5;
    const int lr = tid >> 3, lc = (tid & 7) * 8;
    const bf16_t* ap[4];
    const bf16_t* bp[NBL];
#pragma unroll
    for (int p = 0; p < 4; ++p) ap[p] = A + (size_t)arow(p * 32 + lr) * lda + lc;
#pragma unroll
    for (int p = 0; p < NBL; ++p) bp[p] = Bt + (size_t)(col0 + p * 32 + lr) * ldb + lc;
    u32x4 ra0[4], rb0[NBL], ra1[4], rb1[NBL];
#define G_LOAD(RA, RB, KT) { _Pragma("unroll") for (int p = 0; p < 4; ++p) RA[p] = *(const u32x4*)(ap[p] + (KT) * 64); _Pragma("unroll") for (int p = 0; p < NBL; ++p) RB[p] = *(const u32x4*)(bp[p] + (KT) * 64); }
#define G_STORE(RA, RB, BUF) { bf16_t* wa = sa + (BUF) * 128 * 72; bf16_t* wb = sb + (BUF) * BROWS * 72; _Pragma("unroll") for (int p = 0; p < 4; ++p) *(u32x4*)(wa + (p * 32 + lr) * 72 + lc) = RA[p]; _Pragma("unroll") for (int p = 0; p < NBL; ++p) *(u32x4*)(wb + (p * 32 + lr) * 72 + lc) = RB[p]; }
#define G_COMPUTE(BUF) { __builtin_amdgcn_s_setprio(1); const bf16_t* ca = sa + (BUF) * 128 * 72 + (wr * 64 + r32) * 72 + hh * 8; const bf16_t* cb = sb + (BUF) * BROWS * 72 + (wc * 32 * NTW + r32) * 72 + hh * 8; \
        _Pragma("unroll") for (int ks = 0; ks < 4; ++ks) { const bf16x8 a0 = *(const bf16x8*)(ca + ks * 16), a1 = *(const bf16x8*)(ca + 32 * 72 + ks * 16); \
            _Pragma("unroll") for (int nt = 0; nt < NTW; ++nt) { const bf16x8 b0 = *(const bf16x8*)(cb + nt * 32 * 72 + ks * 16); acc[0][nt] = MFMA32(a0, b0, acc[0][nt]); acc[1][nt] = MFMA32(a1, b0, acc[1][nt]); } }  __builtin_amdgcn_s_setprio(0); }
    G_LOAD(ra0, rb0, 0);
    G_LOAD(ra1, rb1, 1);
    G_STORE(ra0, rb0, 0);
    __syncthreads();
    for (int kt = 0; kt < nk; kt += 2) {
        if (kt + 2 < nk) G_LOAD(ra0, rb0, kt + 2);
        __builtin_amdgcn_sched_barrier(0);
        G_COMPUTE(0);
        hook(kt, acc);
        G_STORE(ra1, rb1, 1);
        __syncthreads();
        if (kt + 3 < nk) G_LOAD(ra1, rb1, kt + 3);
        __builtin_amdgcn_sched_barrier(0);
        G_COMPUTE(1);
        hook(kt + 1, acc);
        if (kt + 2 < nk) G_STORE(ra0, rb0, 0);
        __syncthreads();
    }
#undef G_LOAD
#undef G_STORE
#undef G_COMPUTE
}

template <int NTW, class AR, class HK>
DI void gemm_main1(const bf16_t* __restrict__ A, int lda, AR arow, const bf16_t* __restrict__ Bt, int ldb, int col0, int nk,
                  f32x16 (&acc)[2][NTW], unsigned char* smraw, HK hook, int tid) {
    constexpr int BROWS = 64 * NTW, NBL = 2 * NTW;
    bf16_t* sa = (bf16_t*)smraw;
    bf16_t* sb = sa + 2 * 128 * 72;
    const int lane = tid & 63, wave = __builtin_amdgcn_readfirstlane(tid >> 6), wr = wave >> 1, wc = wave & 1, r32 = lane & 31, hh = lane >> 5;
    const int lr = tid >> 3, lc = (tid & 7) * 8;
    const bf16_t* ap[4];
    const bf16_t* bp[NBL];
#pragma unroll
    for (int p = 0; p < 4; ++p) ap[p] = A + (size_t)arow(p * 32 + lr) * lda + lc;
#pragma unroll
    for (int p = 0; p < NBL; ++p) bp[p] = Bt + (size_t)(col0 + p * 32 + lr) * ldb + lc;
    u32x4 ra[4], rb[NBL];
#pragma unroll
    for (int p = 0; p < 4; ++p) ra[p] = *(const u32x4*)(ap[p]);
#pragma unroll
    for (int p = 0; p < NBL; ++p) rb[p] = *(const u32x4*)(bp[p]);
#pragma unroll
    for (int p = 0; p < 4; ++p) *(u32x4*)(sa + (p * 32 + lr) * 72 + lc) = ra[p];
#pragma unroll
    for (int p = 0; p < NBL; ++p) *(u32x4*)(sb + (p * 32 + lr) * 72 + lc) = rb[p];
    __syncthreads();
    for (int kt = 0; kt < nk; ++kt) {
        const int buf = kt & 1;
        if (kt + 1 < nk) {
#pragma unroll
            for (int p = 0; p < 4; ++p) ra[p] = *(const u32x4*)(ap[p] + (kt + 1) * 64);
#pragma unroll
            for (int p = 0; p < NBL; ++p) rb[p] = *(const u32x4*)(bp[p] + (kt + 1) * 64);
        }
        __builtin_amdgcn_sched_barrier(0);
        const bf16_t* ca = sa + buf * 128 * 72 + (wr * 64 + r32) * 72 + hh * 8;
        const bf16_t* cb = sb + buf * BROWS * 72 + (wc * 32 * NTW + r32) * 72 + hh * 8;
#pragma unroll
        for (int ks = 0; ks < 4; ++ks) {
            const bf16x8 a0 = *(const bf16x8*)(ca + ks * 16), a1 = *(const bf16x8*)(ca + 32 * 72 + ks * 16);
#pragma unroll
            for (int nt = 0; nt < NTW; ++nt) {
                const bf16x8 b0 = *(const bf16x8*)(cb + nt * 32 * 72 + ks * 16);
                acc[0][nt] = MFMA32(a0, b0, acc[0][nt]);
                acc[1][nt] = MFMA32(a1, b0, acc[1][nt]);
            }
        }
        hook(kt, acc);
        if (kt + 1 < nk) {
            bf16_t* wa = sa + (buf ^ 1) * 128 * 72;
            bf16_t* wb = sb + (buf ^ 1) * BROWS * 72;
#pragma unroll
            for (int p = 0; p < 4; ++p) *(u32x4*)(wa + (p * 32 + lr) * 72 + lc) = ra[p];
#pragma unroll
            for (int p = 0; p < NBL; ++p) *(u32x4*)(wb + (p * 32 + lr) * 72 + lc) = rb[p];
        }
        __syncthreads();
    }
}

struct RowPlain { int r0; DI int operator()(int r) const { return r0 + r; } };
struct RowClamp { int base, t0; DI int operator()(int r) const { int t = t0 + r; t = t < 0 ? 0 : (t > S - 1 ? S - 1 : t); return base + t; } };

DI void zero_acc(f32x16 (&acc)[2][2]) {
#pragma unroll
    for (int a = 0; a < 2; ++a)
#pragma unroll
        for (int b = 0; b < 2; ++b)
#pragma unroll
            for (int i = 0; i < 16; ++i) acc[a][b][i] = 0.f;
}

DI void attn_pass(const bf16_t* __restrict__ Qp, int qs, const bf16_t* __restrict__ Kp, int ksr, const bf16_t* __restrict__ Vt,
                  const float* __restrict__ cum, const unsigned* __restrict__ selm, float scale, int nks, int mode, int q0,
                  f32x16 (&O)[2], unsigned char* smraw, int wave, int lane, int tid) {
    constexpr int KROW = 104, KT = 64 * KROW, VT = 64 * 68;
    bf16_t* sK = (bf16_t*)smraw;
    bf16_t* sV = sK + 2 * KT;
    float* sC = (float*)(smraw + 2 * KT * 2 + 2 * VT * 2);
    const int r32 = lane & 31, hh = lane >> 5;
    const int qw = q0 + wave * 32, t = qw + r32;
    bf16x8* sQ = (bf16x8*)(smraw + 2 * KT * 2 + 2 * VT * 2 + 512) + wave * 6 * 64 + lane;
#pragma unroll
    for (int ks = 0; ks < 6; ++ks) if (ks < nks) sQ[ks * 64] = *(const bf16x8*)(Qp + (size_t)t * qs + ks * 16 + hh * 8);
    float cq = 0.f; unsigned smk = 0xffffffffu;
    if (mode == 1) cq = cum[t];
    if (mode == 2) smk = selm[t];
    const int win = (mode == 3) ? 512 : (1 << 30);
    const float c2 = scale * 1.4426950408889634f, ic2 = 1.f / scale;
    int kt0 = 0; const int kt1 = q0 / 64 + 2;
    if (mode == 3) { kt0 = q0 / 64 - 8; if (kt0 < 0) kt0 = 0; }
#pragma unroll
    for (int i = 0; i < 16; ++i) { O[0][i] = 0.f; O[1][i] = 0.f; }
    float m = -1e30f, l = 0.f;
    const int nkc = nks >> 1, cpr = nks * 2;
    int krc[3];
#pragma unroll
    for (int p = 0; p < 3; ++p) { const int c = p * 256 + tid, row = c / cpr, cc = c - row * cpr; krc[p] = row | (cc << 8); }
#define KG(p) ((krc[p] & 255) * ksr + (krc[p] >> 8) * 8)
#define KL(p) ((krc[p] & 255) * KROW + (krc[p] >> 8) * 8)
#define VG(p) ((((p) * 256 + tid) >> 3) * S + (((p) * 256 + tid) & 7) * 8)
#define VL(p) ((((p) * 256 + tid) >> 3) * 68 + (((p) * 256 + tid) & 7) * 8)
    u32x4 rk[3], rv[2]; float rc = 0.f;
    {
        const bf16_t* kp = Kp + (size_t)kt0 * 64 * ksr; const bf16_t* vp = Vt + kt0 * 64;
#pragma unroll
        for (int p = 0; p < 3; ++p) if (p < nkc) rk[p] = *(const u32x4*)(kp + KG(p));
#pragma unroll
        for (int p = 0; p < 2; ++p) rv[p] = *(const u32x4*)(vp + VG(p));
        if (mode == 1 && tid < 64) rc = cum[kt0 * 64 + tid];
#pragma unroll
        for (int p = 0; p < 3; ++p) if (p < nkc) *(u32x4*)(sK + KL(p)) = rk[p];
#pragma unroll
        for (int p = 0; p < 2; ++p) { u32x2* d = (u32x2*)(sV + VL(p)); d[0] = (u32x2){rv[p][0], rv[p][1]}; d[1] = (u32x2){rv[p][2], rv[p][3]}; }
        if (mode == 1 && tid < 64) sC[tid] = rc;
    }
    __syncthreads();
    for (int kt = kt0; kt < kt1; ++kt) {
        const int buf = (kt - kt0) & 1;
        if (kt + 1 < kt1) {
            const bf16_t* kp = Kp + (size_t)(kt + 1) * 64 * ksr; const bf16_t* vp = Vt + (kt + 1) * 64;
#pragma unroll
            for (int p = 0; p < 3; ++p) if (p < nkc) rk[p] = *(const u32x4*)(kp + KG(p));
#pragma unroll
            for (int p = 0; p < 2; ++p) rv[p] = *(const u32x4*)(vp + VG(p));
            if (mode == 1 && tid < 64) rc = cum[(kt + 1) * 64 + tid];
        }
        bool act = (kt * 64 <= qw + 31) && (kt * 64 + 63 > qw - win);
        const bool selb = ((smk >> kt) & 1u) != 0u;
        const unsigned long long selbal = __ballot(selb);
        act = act && (selbal != 0ull);
        if (act) {
            const bool full = (kt * 64 + 63 <= qw) && (kt * 64 > qw + 31 - win) && (selbal == ~0ull);
#pragma nounroll
            for (int kb = 0; kb < 2; ++kb) {
                f32x16 Sx;
#pragma unroll
                for (int i = 0; i < 16; ++i) Sx[i] = 0.f;
                const bf16_t* kr = sK + buf * KT + (kb * 32 + r32) * KROW + hh * 8;
#pragma unroll
                for (int ks = 0; ks < 6; ++ks) if (ks < nks) { const bf16x8 a = *(const bf16x8*)(kr + ks * 16); const bf16x8 qv = sQ[ks * 64]; Sx = MFMA32(a, qv, Sx); }
                if (mode == 1) {
#pragma unroll
                    for (int g = 0; g < 4; ++g) {
                        const f32x4 ck = *(const f32x4*)(sC + buf * 64 + kb * 32 + 8 * g + 4 * hh);
#pragma unroll
                        for (int e = 0; e < 4; ++e) Sx[4 * g + e] += (cq - ck[e]) * ic2;
                    }
                }
                if (!full) {
                    const int kbase = kt * 64 + kb * 32 + 4 * hh;
#pragma unroll
                    for (int i = 0; i < 16; ++i) {
                        const int key = kbase + (i & 3) + 8 * (i >> 2);
                        const bool ok = (key <= t) && (key > t - win) && selb;
                        Sx[i] = ok ? Sx[i] : -3e38f;
                    }
                }
                float mx = -3e38f;
#pragma unroll
                for (int i = 0; i < 16; ++i) mx = fmaxf(mx, Sx[i]);
                mx = fmaxf(mx, __shfl_xor(mx, 32));
                mx = fmaxf(mx * c2, -1e30f);
                if (__ballot(mx - m > 10.0f) != 0ull) {
                    const float mn = fmaxf(m, mx), alpha = __builtin_amdgcn_exp2f(m - mn);
                    m = mn;
#pragma unroll
                    for (int i = 0; i < 16; ++i) { O[0][i] *= alpha; O[1][i] *= alpha; }
                    l *= alpha;
                }
                const float mneg = -m;
                float rs = 0.f;
#pragma unroll
                for (int i = 0; i < 16; ++i) { const float pp = __builtin_amdgcn_exp2f(fmaf(Sx[i], c2, mneg)); Sx[i] = pp; rs += pp; }
                l += rs;
#pragma unroll
                for (int s2 = 0; s2 < 2; ++s2) {
                    u32x4 pw;
                    pw[0] = pk2(Sx[8 * s2 + 0], Sx[8 * s2 + 1]); pw[1] = pk2(Sx[8 * s2 + 2], Sx[8 * s2 + 3]);
                    pw[2] = pk2(Sx[8 * s2 + 4], Sx[8 * s2 + 5]); pw[3] = pk2(Sx[8 * s2 + 6], Sx[8 * s2 + 7]);
                    const bf16x8 pb = __builtin_bit_cast(bf16x8, pw);
#pragma unroll
                    for (int dvb = 0; dvb < 2; ++dvb) {
                        const bf16_t* vr = sV + buf * VT + (dvb * 32 + r32) * 68 + kb * 32 + 16 * s2 + 4 * hh;
                        const s16x4 lo = *(const s16x4*)vr, hi = *(const s16x4*)(vr + 8);
                        const bf16x8 va = __builtin_shufflevector(lo, hi, 0, 1, 2, 3, 4, 5, 6, 7);
                        O[dvb] = MFMA32(va, pb, O[dvb]);
                    }
                }
            }
        }
        if (kt + 1 < kt1) {
            const int nb = buf ^ 1;
#pragma unroll
            for (int p = 0; p < 3; ++p) if (p < nkc) *(u32x4*)(sK + nb * KT + KL(p)) = rk[p];
#pragma unroll
            for (int p = 0; p < 2; ++p) { u32x2* d = (u32x2*)(sV + nb * VT + VL(p)); d[0] = (u32x2){rv[p][0], rv[p][1]}; d[1] = (u32x2){rv[p][2], rv[p][3]}; }
            if (mode == 1 && tid < 64) sC[nb * 64 + tid] = rc;
        }
        __syncthreads();
    }
    l += __shfl_xor(l, 32);
    const float inv = 1.f / l;
#pragma unroll
    for (int i = 0; i < 16; ++i) { O[0][i] *= inv; O[1][i] *= inv; }
}

DI void store_o(bf16_t* dst, const f32x16 (&O)[2], int hh) {
#pragma unroll
    for (int dvb = 0; dvb < 2; ++dvb)
#pragma unroll
        for (int g = 0; g < 4; ++g) {
            u32x2 w = {pk2(O[dvb][4 * g], O[dvb][4 * g + 1]), pk2(O[dvb][4 * g + 2], O[dvb][4 * g + 3])};
            *(u32x2*)(dst + dvb * 32 + 8 * g + 4 * hh) = w;
        }
}

template <int GW>
DI float norm_rope(float v, const float* __restrict__ gain, const f32x2* __restrict__ rope_tok, int nrot, int ra, int lane) {
    float ss = v * v;
    ss = (GW == 64) ? wsum(ss) : sum32(ss);
    const int j = lane & (GW - 1);
    float y = v * rsqrtf(ss * (1.f / GW) + EPS) * gain[j];
    if (nrot) {
        const int half = nrot >> 1;
        const float partner = __shfl_xor(y, half);
        if (j < nrot) {
            const f32x2 cs = rope_tok[ra + (j & (half - 1))];
            y = (j < half) ? (y * cs[0] - partner * cs[1]) : (y * cs[0] + partner * cs[1]);
        }
    }
    return y;
}

DI bool xcd_unit(int k, int R, int ntn, int& tmg, int& tn) {
    const int x = blockIdx.x & 7, j = (int)(blockIdx.x >> 3) + k * (int)(gridDim.x >> 3);
    if (j >= R * ntn) return false;
    const int g0 = (R + 1) >> 1;
    int w = j, r0 = 0, gs = g0;
    if (j >= g0 * ntn) { w = j - g0 * ntn; r0 = g0; gs = R - g0; }
    tn = w / gs; tmg = x * R + r0 + (w - tn * gs);
    return true;
}

DI unsigned xb_ld(unsigned* p) { return __hip_atomic_load(p, __ATOMIC_RELAXED, __HIP_MEMORY_SCOPE_AGENT); }
DI unsigned xb_add(unsigned* p, unsigned v) { return __hip_atomic_fetch_add(p, v, __ATOMIC_RELAXED, __HIP_MEMORY_SCOPE_AGENT); }
DI unsigned xcc_id() { return (unsigned)__builtin_amdgcn_s_getreg((3 << 11) | 20) & 0xFu; }
DI void xbar(unsigned* bar, unsigned x, unsigned nloc, unsigned nx, int tid) {
    asm volatile("s_waitcnt vmcnt(0)" ::: "memory");
    __syncthreads();
    if (tid == 0) {
        __builtin_amdgcn_s_waitcnt(0);
        const unsigned old = xb_add(&bar[1024 + 64 * x], 1u);
        const unsigned gen = old / nloc;
        if (old + 1u == (gen + 1u) * nloc) {
            __builtin_amdgcn_fence(__ATOMIC_RELEASE, "agent");
            asm volatile("s_waitcnt vmcnt(0)" ::: "memory");
            const unsigned og = xb_add(&bar[3072], 1u);
            const unsigned tg = og / nx;
            if (og + 1u == (tg + 1u) * nx) xb_add(&bar[3136], 1u);
            else while (xb_ld(&bar[3136]) == tg) __builtin_amdgcn_s_sleep(1);
            __builtin_amdgcn_fence(__ATOMIC_ACQUIRE, "agent");
            xb_add(&bar[2048 + 64 * x], 1u);
            asm volatile("s_waitcnt vmcnt(0)" ::: "memory");
        } else {
            while (xb_ld(&bar[2048 + 64 * x]) == gen) __builtin_amdgcn_s_sleep(1);
            __builtin_amdgcn_fence(__ATOMIC_ACQUIRE, "agent");
            asm volatile("s_waitcnt vmcnt(0)" ::: "memory");
        }
    }
    __syncthreads();
}

__global__ void __launch_bounds__(NT, 2) mega(Params p) {
    extern __shared__ __attribute__((aligned(16))) unsigned char smem[];
    cg::grid_group grid = cg::this_grid();
    bool probe_second = false;
    int nbar = 0;
    unsigned* xbw = (unsigned*)(p.ws + WS_BAR);
    const unsigned xcc = (unsigned)__builtin_amdgcn_readfirstlane((int)xcc_id());
    unsigned xb_nloc = 1u, xb_nx = 1u;
    if (threadIdx.x == 0) xb_add(&xbw[64 * xcc], 1u);
    const int wave_s = __builtin_amdgcn_readfirstlane((int)(threadIdx.x >> 6));
    for (int ph = p.ph_lo; ph < p.ph_hi; ++ph) {
        int zop = 0; asm volatile("" : "+s"(zop));
        const int tid = wave_s * 64 + (int)__builtin_amdgcn_mbcnt_hi(~0u, __builtin_amdgcn_mbcnt_lo(~0u, (unsigned)zop));
        if (ph > p.ph_lo || probe_second) {
            if (nbar == 0) {
                grid.sync();
                unsigned cnt = 0u, mine = 1u;
                for (unsigned j = 0; j < 16; ++j) { const unsigned c = xb_ld(&xbw[64 * j]); cnt += (c > 0u) ? 1u : 0u; if (j == xcc) mine = c; }
                xb_nloc = (unsigned)__builtin_amdgcn_readfirstlane((int)(mine > 0u ? mine : 1u));
                xb_nx = (unsigned)__builtin_amdgcn_readfirstlane((int)(cnt > 0u ? cnt : 1u));
            } else xbar(xbw, xcc, xb_nloc, xb_nx, tid);
            ++nbar;
        }
        const int lane = tid & 63, wave = __builtin_amdgcn_readfirstlane(tid >> 6), r32 = lane & 31, hh = lane >> 5;
        const int wr = wave >> 1, wc = wave & 1;
        unsigned char* ws = p.ws;
        unsigned* ctr = (unsigned*)(ws + WS_CTR);
        float* modb = (float*)(ws + WS_MOD);
        f32x2* rope = (f32x2*)(ws + WS_ROPE);
        bf16_t* Wb = (bf16_t*)(ws + WS_W);
        bf16_t* w_in_t = (bf16_t*)(ws + WS_W + W_IN);
        bf16_t* w_g_t = (bf16_t*)(ws + WS_W + W_G);
        bf16_t* w_br_t = (bf16_t*)(ws + WS_W + W_BR);
        bf16_t* w_o_t = (bf16_t*)(ws + WS_W + W_O);
        bf16_t* w_up_t = (bf16_t*)(ws + WS_W + W_UP);
        bf16_t* w_dn_t = (bf16_t*)(ws + WS_W + W_DN);
        bf16_t* w_uq_t = (bf16_t*)(ws + WS_W + W_UQ);
        bf16_t* w_ukv_t = (bf16_t*)(ws + WS_W + W_UKV);
        (void)Wb;
        bf16_t* hbuf = (bf16_t*)(ws + WS_H);
        float* parts = (float*)(ws + WS_R1);
        bf16_t* gates = (bf16_t*)(ws + WS_R1 + R1_GATES);
        bf16_t* obuf = (bf16_t*)(ws + WS_R1 + R1_OBUF);
        bf16_t* abuf = (bf16_t*)(ws + WS_R1 + R1_ABUF);
        unsigned char* r2 = ws + WS_R2;
        bf16_t* qnsa = (bf16_t*)(r2 + R2_QNSA);
        float* qfnsa = (float*)(r2 + R2_QFNSA);
        bf16_t* ksb = (bf16_t*)(r2 + R2_KS);
        bf16_t* kwb = (bf16_t*)(r2 + R2_KW);
        bf16_t* vts = (bf16_t*)(r2 + R2_VTS);
        bf16_t* vtw = (bf16_t*)(r2 + R2_VTW);
        float* gn = (float*)(r2 + R2_GN);
        float* kcmp = (float*)(r2 + R2_KCMP);
        float* vcmp = (float*)(r2 + R2_VCMP);
        float* ocmp = (float*)(r2 + R2_OCMP);
        unsigned* selm = (unsigned*)(r2 + R2_SELM);
        bf16_t* fq = (bf16_t*)(r2 + R2_FQ);
        bf16_t* fk = (bf16_t*)(r2 + R2_FK);
        bf16_t* fvt = (bf16_t*)(r2 + R2_FVT);
        float* cumb = (float*)(r2 + R2_CUM);
        bf16_t* mq = (bf16_t*)(r2 + R2_MQ);
        bf16_t* mk = (bf16_t*)(r2 + R2_MK);
        bf16_t* mvt = (bf16_t*)(r2 + R2_MVT);
        bf16_t* dq = (bf16_t*)(r2 + R2_DQ);
        bf16_t* dkb = (bf16_t*)(r2 + R2_DK);
        bf16_t* dvt = (bf16_t*)(r2 + R2_DVT);
        float* dtmp = (float*)(r2 + R2_DTMP);
        float* ntmp = (float*)(r2 + R2_NTMP);

        const float* x_in = p.in[0];
        const float* c_in = p.in[1];
        const int* pos_in = (const int*)p.in[2];
        float* xo = p.out;

        if (ph == 0) {
            if (!EN(0)) continue;
            if (blockIdx.x == 0 && tid < 16) ctr[tid] = 0u;
            for (int idx = blockIdx.x * NT + tid; idx < M * 28; idx += gridDim.x * NT) {
                const int tok = idx / 28, a = idx % 28;
                float e;
                if (a < 8) e = -(float)a / 8.f; else if (a < 24) e = -(float)(a - 8) / 16.f; else e = -(float)(a - 24) / 4.f;
                const float inv_freq = powf(500000.f, e);
                const float ang = (float)pos_in[tok] * inv_freq;
                rope[idx] = (f32x2){cosf(ang), sinf(ang)};
            }
            float* sc = (float*)smem;
            float* red = sc + 8 * 1024;
            for (int i = tid; i < 8192; i += NT) sc[i] = siluf_(c_in[i]);
            __syncthreads();
            for (int job = blockIdx.x; job < NL * 96; job += gridDim.x) {
                const int l = job / 96, cgp = job % 96;
                const int kq = tid >> 6, j = tid & 63, col = cgp * 64 + j;
                float acc[8];
#pragma unroll
                for (int b = 0; b < 8; ++b) acc[b] = 0.f;
                const float* wp = p.in[3] + ((size_t)l * 1024 + kq * 256) * 6144 + col;
                for (int k = 0; k < 256; ++k) {
                    const float w = wp[(size_t)k * 6144];
#pragma unroll
                    for (int b = 0; b < 8; ++b) acc[b] += sc[b * 1024 + kq * 256 + k] * w;
                }
#pragma unroll
                for (int b = 0; b < 8; ++b) red[(kq * 8 + b) * 64 + j] = acc[b];
                __syncthreads();
                if (kq == 0) {
#pragma unroll
                    for (int b = 0; b < 8; ++b) {
                        const float v = red[(0 * 8 + b) * 64 + j] + red[(1 * 8 + b) * 64 + j] + red[(2 * 8 + b) * 64 + j] + red[(3 * 8 + b) * 64 + j];
                        modb[((size_t)l * 8 + b) * 6144 + col] = v + p.in[4][l * 6144 + col];
                    }
                }
                __syncthreads();
            }
            if (PROBE_SUB == 100 && !probe_second) { probe_second = true; --ph; } else probe_second = false;
            continue;
        }
        const int l = (ph - 1) / 10, sub = (ph - 1) % 10;
        const float* xcur = (l == 0) ? x_in : xo;
        const float* modl = modb + (size_t)l * 8 * 6144;
        if ((sub == 0 || sub == 7) && EN(1)) {
            if (sub == 0) {
                float* tsm = (float*)smem;
                tc_matrix(p.in[5] + (size_t)l * 1024 * NIN, 1024, NIN, w_in_t, 1024, tsm, 0, tid);
                for (int i = blockIdx.x * NT + tid; i < 64 * 1024 / 8; i += gridDim.x * NT) ((u32x4*)(w_in_t + (size_t)2624 * 1024))[i] = (u32x4){0u, 0u, 0u, 0u};
                tc_matrix(p.in[21] + (size_t)l * 1024 * 4096, 1024, 4096, w_g_t, 1024, tsm, 0, tid);
                tc_matrix(p.in[20] + (size_t)l * 1024 * 1024, 1024, 1024, w_br_t, 1024, tsm, 0, tid);
                tc_matrix(p.in[23] + (size_t)l * 1024 * 1024, 1024, 1024, w_o_t, 1024, tsm, 0, tid);
                tc_matrix(p.in[24] + (size_t)l * 1024 * 5632, 1024, 5632, w_up_t, 1024, tsm, 1, tid);
                tc_matrix(p.in[27] + (size_t)l * DFF * 1024, DFF, 1024, w_dn_t, DFF, tsm, 0, tid);
                tc_matrix(p.in[14] + (size_t)l * 256 * 384, 256, 384, w_uq_t, 256, tsm, 0, tid);
                tc_matrix(p.in[15] + (size_t)l * 128 * 512, 128, 512, w_ukv_t, 128, tsm, 0, tid);
            }
            const float* xs = (sub == 0) ? xcur : xo;
            const int osh = (sub == 0) ? 0 : 3072, osc = osh + 1024;
            for (int tok = blockIdx.x * 4 + wave; tok < M; tok += gridDim.x * 4) {
                const int b = tok / S;
                const f32x4* xr = (const f32x4*)(xs + (size_t)tok * D);
                f32x4 v[4]; float ss = 0.f;
#pragma unroll
                for (int i = 0; i < 4; ++i) { v[i] = xr[lane + 64 * i]; ss += v[i][0] * v[i][0] + v[i][1] * v[i][1] + v[i][2] * v[i][2] + v[i][3] * v[i][3]; }
                ss = wsum(ss);
                const float rstd = rsqrtf(ss * (1.f / D) + EPS);
                const float* mb = modl + (size_t)b * 6144;
#pragma unroll
                for (int i = 0; i < 4; ++i) {
                    const int col = (lane + 64 * i) * 4;
                    const f32x4 scv = *(const f32x4*)(mb + osc + col), shv = *(const f32x4*)(mb + osh + col);
                    float o[4];
#pragma unroll
                    for (int e = 0; e < 4; ++e) o[e] = v[i][e] * rstd * (1.f + scv[e]) + shv[e];
                    *(u32x2*)(hbuf + (size_t)tok * D + col) = (u32x2){pk2(o[0], o[1]), pk2(o[2], o[3])};
                }
            }
        } else if (sub == 1 && EN(2)) {
            const int ntn = NINP / 128;
            for (int k = 0;; ++k) {
                int tm, tn; if (!xcd_unit(k, 16, ntn, tm, tn)) break;
                f32x16 acc[2][2]; zero_acc(acc);
                gemm_main<2>(hbuf, D, RowPlain{tm * 128}, w_in_t, D, tn * 128, D / 64, acc, smem, NoHook{}, tid);
#pragma unroll
                for (int mt = 0; mt < 2; ++mt)
#pragma unroll
                    for (int nt = 0; nt < 2; ++nt)
#pragma unroll
                        for (int i = 0; i < 16; ++i) {
                            const int row = tm * 128 + wr * 64 + mt * 32 + crow(i, hh), col = tn * 128 + wc * 64 + nt * 32 + r32;
                            parts[(size_t)row * NINP + col] = acc[mt][nt][i];
                        }
            }
        } else if (sub == 2 && EN(3)) {
            const int NJ_MLA = 2 * (M / 64), NJ_CMP = NB * 2 * 32, NJ_TC = 10 * (M / 256), NJ_TOK = M / 32, NJ_CUM = 8;
            const int NJ = NJ_MLA + NJ_CMP + NJ_TC + NJ_TOK + NJ_CUM;
            unsigned* sj = (unsigned*)(smem + LDS_BYTES - 16);
            for (;;) {
                __syncthreads();
                if (tid == 0) *sj = atomicAdd(&ctr[16 + l + (probe_second ? 4 : 0)], 1u);
                __syncthreads();
                const int job = __builtin_amdgcn_readfirstlane((int)*sj);
                if (job >= NJ) break;
                int jj = job;
                if (jj < NJ_CUM) {
                {
                    const int bh = jj * 4 + wave, b = bh >> 2, hd = bh & 3;
                    const float fb = p.in[11][l * 4 + hd];
                    float vals[32]; float run = 0.f;
#pragma unroll
                    for (int i = 0; i < 32; ++i) {
                        const int t = lane * 32 + i;
                        const float xv = parts[(size_t)(b * S + t) * NINP + 1420 + hd] + fb;
                        const float ls = fminf(xv, 0.f) - log1pf(__expf(-fabsf(xv)));
                        run += ls; vals[i] = run;
                    }
                    float incl = run;
#pragma unroll
                    for (int o = 1; o < 64; o <<= 1) { const float v = __shfl_up(incl, o); if (lane >= o) incl += v; }
                    const float off = incl - run;
#pragma unroll
                    for (int i = 0; i < 32; ++i) cumb[(size_t)bh * S + lane * 32 + i] = off + vals[i];
                }
                    continue;
                }
                jj -= NJ_CUM;
                if (jj < NJ_MLA + NJ_CMP) {
                    const int seg = jj >> 8, off = jj & 255;
                    jj = (seg & 1) ? NJ_MLA + (seg >> 1) * 256 + off : (seg >> 1) * 256 + off;
                }
                if (jj < NJ_MLA) {
                    const bool doq = jj < (M / 64);
                    const int tok0 = (jj & (M / 64 - 1)) * 64, b = tok0 / S, t0 = tok0 % S;
                    bf16_t* aq = (bf16_t*)smem;
                    bf16_t* akv = aq + 64 * 264;
                    float* kr = (float*)(akv + 64 * 136);
                    float* krss = kr + 64 * 32;
                    float* rkk = krss + 64;
                    if (doq) {
                        const f32x4 g = *(const f32x4*)(p.in[12] + l * 256 + lane * 4);
#pragma unroll 1
                        for (int rb = wave * 16; rb < wave * 16 + 16; rb += 8) {
                            f32x4 v[8];
#pragma unroll
                            for (int k = 0; k < 8; ++k) v[k] = *(const f32x4*)(parts + (size_t)(tok0 + rb + k) * NINP + 1424 + lane * 4);
#pragma unroll
                            for (int k = 0; k < 8; ++k) {
                                const float ss = wsum(v[k][0] * v[k][0] + v[k][1] * v[k][1] + v[k][2] * v[k][2] + v[k][3] * v[k][3]);
                                const float rstd = rsqrtf(ss * (1.f / 256.f) + EPS);
                                *(u32x2*)(aq + (rb + k) * 264 + lane * 4) = (u32x2){pk2(v[k][0] * rstd * g[0], v[k][1] * rstd * g[1]), pk2(v[k][2] * rstd * g[2], v[k][3] * rstd * g[3])};
                            }
                        }
                    } else {
                        const f32x2 g2 = *(const f32x2*)(p.in[13] + l * 128 + lane * 2);
#pragma unroll 1
                        for (int rb = wave * 16; rb < wave * 16 + 16; rb += 8) {
                            f32x2 w[8]; float kvv[8];
#pragma unroll
                            for (int k = 0; k < 8; ++k) {
                                const float* pr = parts + (size_t)(tok0 + rb + k) * NINP;
                                w[k] = *(const f32x2*)(pr + 1680 + lane * 2);
                                kvv[k] = (lane < 32) ? pr[1808 + lane] : 0.f;
                            }
#pragma unroll
                            for (int k = 0; k < 8; ++k) {
                                const int r = rb + k;
                                const float ss = wsum(w[k][0] * w[k][0] + w[k][1] * w[k][1]);
                                const float rstd = rsqrtf(ss * (1.f / 128.f) + EPS);
                                *(unsigned*)(akv + r * 136 + lane * 2) = pk2(w[k][0] * rstd * g2[0], w[k][1] * rstd * g2[1]);
                                if (lane < 32) kr[r * 32 + lane] = kvv[k];
                                const float s2 = wsum(kvv[k] * kvv[k]);
                                if (lane == 0) krss[r] = s2;
                            }
                        }
                    }
                    __syncthreads();
                    const float* gq = p.in[16] + (size_t)l * 192;
                    const float* gk = gq + 96;
                    if (doq) {
#pragma unroll 1
                        for (int mt = 0; mt < 2; ++mt) {
                            f32x16 acc[3];
#pragma unroll
                            for (int c = 0; c < 3; ++c)
#pragma unroll
                                for (int i = 0; i < 16; ++i) acc[c][i] = 0.f;
#pragma unroll 8
                            for (int ks = 0; ks < 16; ++ks) {
                                const bf16x8 a0 = *(const bf16x8*)(aq + (mt * 32 + r32) * 264 + ks * 16 + hh * 8);
#pragma unroll
                                for (int nt = 0; nt < 3; ++nt) {
                                    const bf16x8 bb = *(const bf16x8*)(w_uq_t + (size_t)(wave * 96 + nt * 32 + r32) * 256 + ks * 16 + hh * 8);
                                    acc[nt] = MFMA32(a0, bb, acc[nt]);
                                }
                            }
                            const float gq0 = gq[r32], gq1 = gq[32 + r32], gq2 = gq[64 + r32];
#pragma unroll
                            for (int i = 0; i < 16; ++i) {
                                float ss = acc[0][i] * acc[0][i] + acc[1][i] * acc[1][i] + acc[2][i] * acc[2][i];
                                ss = sum32(ss);
                                const float rstd = rsqrtf(ss * (1.f / 96.f) + EPS);
                                const int row = mt * 32 + crow(i, hh), tok = tok0 + row;
                                float y0 = acc[0][i] * rstd * gq0;
                                const float y1 = acc[1][i] * rstd * gq1, y2 = acc[2][i] * rstd * gq2;
                                const float partner = __shfl_xor(y0, 16);
                                const f32x2 cs = rope[(size_t)tok * 28 + 8 + (r32 & 15)];
                                y0 = (r32 < 16) ? (y0 * cs[0] - partner * cs[1]) : (y0 * cs[0] + partner * cs[1]);
                                bf16_t* d = mq + (size_t)tok * 384 + wave * 96 + r32;
                                d[0] = f2bf(y0); d[32] = f2bf(y1); d[64] = f2bf(y2);
                                if ((i & 3) == 3) __builtin_amdgcn_sched_barrier(0);
                            }
                        }
                    }
                    if (!doq) {
#pragma unroll 1
                        for (int mt = 0; mt < 2; ++mt) {
                            f32x16 acc[4];
#pragma unroll
                            for (int c = 0; c < 4; ++c)
#pragma unroll
                                for (int i = 0; i < 16; ++i) acc[c][i] = 0.f;
#pragma unroll 8
                            for (int ks = 0; ks < 8; ++ks) {
                                const bf16x8 a0 = *(const bf16x8*)(akv + (mt * 32 + r32) * 136 + ks * 16 + hh * 8);
#pragma unroll
                                for (int nt = 0; nt < 4; ++nt) {
                                    const bf16x8 bb = *(const bf16x8*)(w_ukv_t + (size_t)(wave * 128 + nt * 32 + r32) * 128 + ks * 16 + hh * 8);
                                    acc[nt] = MFMA32(a0, bb, acc[nt]);
                                }
                            }
#pragma unroll
                            for (int i = 0; i < 16; ++i) {
                                const int row = mt * 32 + crow(i, hh), tok = tok0 + row;
                                float ss = acc[0][i] * acc[0][i] + acc[1][i] * acc[1][i];
                                ss = sum32(ss) + krss[row];
                                const float rstd = rsqrtf(ss * (1.f / 96.f) + EPS);
                                if (r32 == 0) rkk[row * 4 + wave] = rstd;
                                bf16_t* d = mk + (size_t)tok * 384 + wave * 96 + 32 + r32;
                                d[0] = f2bf(acc[0][i] * rstd * gk[32 + r32]);
                                d[32] = f2bf(acc[1][i] * rstd * gk[64 + r32]);
                            }
#pragma unroll
                            for (int nt = 2; nt < 4; ++nt)
#pragma unroll
                                for (int g = 0; g < 4; ++g) {
                                    const int dv = (nt - 2) * 32 + r32, tt = t0 + mt * 32 + 8 * g + 4 * hh;
                                    u32x2 w = {pk2(acc[nt][4 * g], acc[nt][4 * g + 1]), pk2(acc[nt][4 * g + 2], acc[nt][4 * g + 3])};
                                    *(u32x2*)(mvt + ((size_t)(b * 4 + wave) * 64 + dv) * S + tt) = w;
                                }
                        }
                    }
                    __syncthreads();
                    if (!doq)
                    for (int it = tid; it < 64 * 4 * 16; it += NT) {
                        const int row = it >> 6, hd = (it >> 4) & 3, j = it & 15, tok = tok0 + row;
                        const float rstd = rkk[row * 4 + hd];
                        const float x1 = kr[row * 32 + j] * rstd * gk[j], x2 = kr[row * 32 + 16 + j] * rstd * gk[16 + j];
                        const f32x2 cs = rope[(size_t)tok * 28 + 8 + j];
                        bf16_t* d = mk + (size_t)tok * 384 + hd * 96;
                        d[j] = f2bf(x1 * cs[0] - x2 * cs[1]);
                        d[16 + j] = f2bf(x2 * cs[0] + x1 * cs[1]);
                    }
                    __syncthreads();
                    continue;
                }
                jj -= NJ_MLA;
                if (jj < NJ_CMP) {
                    const int b = jj / 64, which = (jj / 32) & 1, c0 = (jj & 31) * 4;
                    float* B4 = (float*)smem;
                    float* red = B4 + 4 * 2048;
                    float* hid = red + 4 * 4 * 64;
                    const int colb = which ? 320 : 256;
                    const float* pe = p.in[7] + ((size_t)l * 2 + which) * 2048;
                    const float* w1 = p.in[8] + ((size_t)l * 2 + which) * 2048 * 64;
                    const float* w2 = p.in[9] + ((size_t)l * 2 + which) * 64 * 64;
#pragma unroll 1
                    for (int i0 = 0; i0 < 4 * 2048; i0 += 8 * NT) {
                        float xv[8], pv[8];
#pragma unroll
                        for (int k = 0; k < 8; ++k) {
                            const int i = i0 + k * NT + tid, ci = i >> 11, ii = i & 2047, pos = ii >> 6, d = ii & 63, t = (c0 + ci) * 16 + pos;
                            xv[k] = (t < S) ? parts[(size_t)(b * S + t) * NINP + colb + d] : 0.f; pv[k] = pe[ii];
                        }
#pragma unroll
                        for (int k = 0; k < 8; ++k) B4[i0 + k * NT + tid] = xv[k] + pv[k];
                    }
                    __syncthreads();
                    {
                        float a0 = 0.f, a1 = 0.f, a2 = 0.f, a3 = 0.f;
                        const float* wp = w1 + (size_t)(wave * 512) * 64 + lane;
                        const float* bp = B4 + wave * 512;
#pragma unroll 8
                        for (int i4 = 0; i4 < 128; ++i4) {
                            const f32x4 x0 = *(const f32x4*)(bp + i4 * 4), x1 = *(const f32x4*)(bp + 2048 + i4 * 4);
                            const f32x4 x2 = *(const f32x4*)(bp + 4096 + i4 * 4), x3 = *(const f32x4*)(bp + 6144 + i4 * 4);
#pragma unroll
                            for (int e = 0; e < 4; ++e) {
                                const float wv = wp[(size_t)(i4 * 4 + e) * 64];
                                a0 = fmaf(x0[e], wv, a0); a1 = fmaf(x1[e], wv, a1); a2 = fmaf(x2[e], wv, a2); a3 = fmaf(x3[e], wv, a3);
                            }
                        }
                        red[(wave * 4 + 0) * 64 + lane] = a0; red[(wave * 4 + 1) * 64 + lane] = a1;
                        red[(wave * 4 + 2) * 64 + lane] = a2; red[(wave * 4 + 3) * 64 + lane] = a3;
                    }
                    __syncthreads();
                    {
                        const int ci = wave, j = lane, c = c0 + ci;
                        const float hsum = red[(0 * 4 + ci) * 64 + j] + red[(1 * 4 + ci) * 64 + j] + red[(2 * 4 + ci) * 64 + j] + red[(3 * 4 + ci) * 64 + j];
                        hid[ci * 64 + j] = siluf_(hsum);
                        __syncthreads();
                        float o = 0.f;
#pragma unroll 16
                        for (int i = 0; i < 64; ++i) o += hid[ci * 64 + i] * w2[i * 64 + j];
                        if (which == 0) {
                            const float ss = wsum(o * o);
                            o = o * rsqrtf(ss * (1.f / 64.f) + EPS) * p.in[6][(size_t)l * 256 + 64 + j];
                        }
                        if (c < 127) (which ? vcmp : kcmp)[((size_t)b * 128 + c) * 64 + j] = o;
                    }
                    __syncthreads();
                    continue;
                }
                jj -= NJ_CMP;
                if (jj < 1024) {
                    const int seg = jj >> 8, off = jj & 255;
                    jj = (seg & 1) ? NJ_TC + (seg >> 1) * 256 + off : (seg >> 1) * 256 + off;
                } else jj -= 512;
                if (jj < NJ_TC) {
                    const int ct = jj / (M / 256), tt4 = jj % (M / 256);
                    const int tok0 = tt4 * 256, b = tok0 / S, t0 = tok0 % S;
                    int col; bf16_t* dst;
                    if (ct == 0) { col = 448; dst = vts + (size_t)b * 64 * S; }
                    else if (ct == 1) { col = 576; dst = vtw + (size_t)b * 64 * S; }
                    else if (ct < 6) { col = 1164 + (ct - 2) * 64; dst = fvt + (size_t)(b * 4 + ct - 2) * 64 * S; }
                    else { col = 2352 + (ct - 6) * 64; dst = dvt + (size_t)(b * 4 + ct - 6) * 64 * S; }
#pragma unroll 1
                    for (int k4 = 0; k4 < 4; ++k4) tc_tile(parts + (size_t)b * S * NINP, NINP, NINP, t0 + k4 * 64, col, dst, S, 0, (float*)smem, tid);
                    continue;
                }
                jj -= NJ_TC;
                if (jj < NJ_TOK) {
#pragma unroll 1
                    for (int ti = 0; ti < 8; ++ti) {
                    const int tok = jj * 32 + wave * 8 + ti;
                    const float* pr = parts + (size_t)tok * NINP;
                    const f32x2* rt = rope + (size_t)tok * 28;
                    const float* ng = p.in[6] + (size_t)l * 256;
                    float vq[4], vfq[4], vfk[4], vdq[4], vdk[4];
#pragma unroll
                    for (int hd = 0; hd < 4; ++hd) {
                        vq[hd] = pr[hd * 64 + lane]; vfq[hd] = pr[652 + hd * 64 + lane]; vfk[hd] = pr[908 + hd * 64 + lane];
                        vdq[hd] = pr[1840 + hd * 64 + lane]; vdk[hd] = pr[2096 + hd * 64 + lane];
                    }
                    const float vks = pr[384 + lane], vkw = pr[512 + lane], vg = (lane < 12) ? pr[640 + lane] : 0.f;
#pragma unroll
                    for (int hd = 0; hd < 4; ++hd) {
                        const float y = norm_rope<64>(vq[hd], ng, rt, 16, 0, lane);
                        qnsa[(size_t)tok * 256 + hd * 64 + lane] = f2bf(y);
                        qfnsa[(size_t)tok * 256 + hd * 64 + lane] = y;
                    }
                    ksb[(size_t)tok * 64 + lane] = f2bf(norm_rope<64>(vks, ng + 128, rt, 16, 0, lane));
                    kwb[(size_t)tok * 64 + lane] = f2bf(norm_rope<64>(vkw, ng + 192, rt, 16, 0, lane));
                    if (lane < 12) gn[(size_t)tok * 12 + lane] = sigmoidf_(vg);
                    const float* fg = p.in[10] + (size_t)l * 128;
#pragma unroll
                    for (int hd = 0; hd < 4; ++hd) {
                        fq[(size_t)tok * 256 + hd * 64 + lane] = f2bf(norm_rope<64>(vfq[hd], fg, rt, 0, 0, lane));
                        fk[(size_t)tok * 256 + hd * 64 + lane] = f2bf(norm_rope<64>(vfk[hd], fg + 64, rt, 0, 0, lane));
                    }
                    const float* dg = p.in[17] + (size_t)l * 64;
#pragma unroll
                    for (int hd = 0; hd < 4; ++hd) {
                        dq[(size_t)tok * 256 + hd * 64 + lane] = f2bf(norm_rope<32>(vdq[hd], dg, rt, 8, 24, lane));
                        dkb[(size_t)tok * 256 + hd * 64 + lane] = f2bf(norm_rope<32>(vdk[hd], dg + 32, rt, 8, 24, lane));
                    }
                    }
                    continue;
                }
            }
        } else if (sub == 3 && EN(4)) {
            const int NJ_C = M / 32;
            const int ntn = 4096 / 128;
            const int nrc = (NJ_C + (int)gridDim.x - 1) / (int)gridDim.x;
            for (int kk = 0;; ++kk) {
                const int job = (kk < nrc) ? (int)blockIdx.x + kk * (int)gridDim.x : NJ_C;
                if (kk < nrc && job >= NJ_C) continue;
                if (job < NJ_C) {
                    const int tokb = job * 32, b = tokb / S;
                    float* P = (float*)smem;
                    {
                        f32x2 kk[64];
                        const f32x4* kp0 = (const f32x4*)(kcmp + ((size_t)b * 128 + lane) * 64);
                        const f32x4* kp1 = (const f32x4*)(kcmp + ((size_t)b * 128 + (lane < 63 ? lane + 64 : 126)) * 64);
#pragma unroll
                        for (int i = 0; i < 16; ++i) {
                            const f32x4 a_ = kp0[i], b_ = kp1[i];
                            kk[4 * i + 0] = (f32x2){a_[0], b_[0]}; kk[4 * i + 1] = (f32x2){a_[1], b_[1]};
                            kk[4 * i + 2] = (f32x2){a_[2], b_[2]}; kk[4 * i + 3] = (f32x2){a_[3], b_[3]};
                        }
#pragma unroll 1
                        for (int ti = 0; ti < 8; ++ti) {
                            const int tok = tokb + wave * 8 + ti, t = tok % S;
                            const int nvis = (t >= 31) ? ((t - 31) / 16 + 1) : 0;
                            const bool v0 = lane < nvis, v1 = (lane + 64) < nvis;
                            float imp = 0.f;
#pragma unroll
                            for (int hd = 0; hd < 4; ++hd) {
                                const float qv = qfnsa[(size_t)tok * 256 + hd * 64 + lane];
                                f32x2 s01 = {0.f, 0.f};
#pragma unroll
                                for (int d = 0; d < 64; ++d) {
                                    const float qd = __builtin_bit_cast(float, __builtin_amdgcn_readlane(__builtin_bit_cast(int, qv), d));
                                    s01 = __builtin_elementwise_fma((f32x2){qd, qd}, kk[d], s01);
                                }
                                float s0 = s01[0], s1 = s01[1];
                                s0 = v0 ? s0 * 0.125f : -1e30f; s1 = v1 ? s1 * 0.125f : -1e30f;
                                const float mx = wmax(fmaxf(s0, s1));
                                const float e0 = v0 ? __expf(s0 - mx) : 0.f, e1 = v1 ? __expf(s1 - mx) : 0.f;
                                const float sm_ = wsum(e0 + e1);
                                const float inv = (nvis > 0) ? 1.f / sm_ : 0.f;
                                float* pr_ = P + (wave * 32 + ti * 4 + hd) * 128;
                                pr_[lane] = e0 * inv; pr_[lane + 64] = e1 * inv;
                            }
                            __syncthreads();
                            if (lane < 32) {
#pragma unroll
                                for (int hd = 0; hd < 4; ++hd) {
                                    const float* pr_ = P + (wave * 32 + ti * 4 + hd) * 128;
#pragma unroll
                                    for (int dc = -1; dc <= 3; ++dc) { const int c = 4 * lane + dc; if (c >= 0 && c <= 126) imp += pr_[c]; }
                                }
                            }
                            const int cur = t >> 6, j = lane;
                            float score;
                            if (j * 64 > t) score = -1.f;
                            else if (j == 0 || j == cur || j == cur - 1) score = 1e4f;
                            else score = imp;
                            if (j >= 32) score = -2.f;
                            int cnt = 0;
#pragma unroll
                            for (int i = 0; i < 32; ++i) {
                                const float si = __builtin_bit_cast(float, __builtin_amdgcn_readlane(__builtin_bit_cast(int, score), i));
                                cnt += (si > score || (si == score && i < j)) ? 1 : 0;
                            }
                            const bool sel = (j < 32) && (cnt < 16) && (j * 64 <= t);
                            const unsigned long long bal = __ballot(sel);
                            if (lane == 0) selm[tok] = (unsigned)bal;
                        }
                    }
                    __syncthreads();
                    {
                        float vcol[128];
#pragma unroll
                        for (int c = 0; c < 127; ++c) vcol[c] = vcmp[((size_t)b * 128 + c) * 64 + lane];
                        vcol[127] = 0.f;
#pragma unroll 1
                        for (int pi = 0; pi < 32; ++pi) {
                            const f32x4* pr_ = (const f32x4*)(P + (wave * 32 + pi) * 128);
                            float o0 = 0.f, o1 = 0.f;
#pragma unroll
                            for (int c4 = 0; c4 < 32; ++c4) {
                                const f32x4 pv = pr_[c4];
                                o0 = fmaf(pv[0], vcol[4 * c4], o0); o1 = fmaf(pv[1], vcol[4 * c4 + 1], o1);
                                o0 = fmaf(pv[2], vcol[4 * c4 + 2], o0); o1 = fmaf(pv[3], vcol[4 * c4 + 3], o1);
                            }
                            const int tok = tokb + wave * 8 + (pi >> 2), hd = pi & 3;
                            ocmp[(size_t)tok * 256 + hd * 64 + lane] = o0 + o1;
                        }
                    }
                    __syncthreads();
                } else break;
            }
        } else if (sub == 4 && EN(5)) {
            unsigned* su = (unsigned*)(smem + LDS_BYTES - 16);
            const float lam_init = __builtin_bit_cast(float, __builtin_amdgcn_readfirstlane(__builtin_bit_cast(int, 0.8f - 0.6f * expf(-0.3f * (float)l))));
            const float one_m_lam = __builtin_bit_cast(float, __builtin_amdgcn_readfirstlane(__builtin_bit_cast(int, 1.f - lam_init)));
            float lam;
            {
                const float* lv = p.in[18] + (size_t)l * 128;
                const int j = lane & 31;
                const float a1 = sum32(lv[j] * lv[32 + j]), a2 = sum32(lv[64 + j] * lv[96 + j]);
                lam = expf(a1) - expf(a2) + lam_init;
                lam = __builtin_bit_cast(float, __builtin_amdgcn_readfirstlane(__builtin_bit_cast(int, lam)));
            }
            const int role = (blockIdx.x >= (gridDim.x >> 1)) ? 1 : 0;
#pragma unroll 1
            for (int step = 0; step < 3; ++step) {
            const int what = role ? (step == 0 ? 2 : (step == 1 ? 1 : 0)) : (step == 0 ? 0 : (step == 1 ? 2 : 1));
            if (what == 2) {
            {
                const int ntn = 4096 / 128;
                for (int k = 0;; ++k) {
                    int tm, tn; if (!xcd_unit(k, 16, ntn, tm, tn)) break;
                    f32x16 acc[2][2]; zero_acc(acc);
                    gemm_main<2>(w_g_t, D, RowPlain{tn * 128}, hbuf, D, tm * 128, D / 64, acc, smem, NoHook{}, tid);
                    const int colb = tn * 128 + wr * 64 + 4 * hh, rowb = tm * 128 + wc * 64 + r32;
                    const float* gb = p.in[22] + (size_t)l * 4096 + colb;
                    bf16_t* gub = gates + (size_t)rowb * GLD + colb;
#pragma unroll
                    for (int mt = 0; mt < 2; ++mt)
#pragma unroll
                        for (int g = 0; g < 4; ++g) {
                            const f32x4 bv = *(const f32x4*)(gb + mt * 32 + 8 * g);
#pragma unroll
                            for (int nt = 0; nt < 2; ++nt) {
                                const float s0 = sigmoidf_(acc[mt][nt][4 * g + 0] + bv[0]), s1 = sigmoidf_(acc[mt][nt][4 * g + 1] + bv[1]);
                                const float s2 = sigmoidf_(acc[mt][nt][4 * g + 2] + bv[2]), s3 = sigmoidf_(acc[mt][nt][4 * g + 3] + bv[3]);
                                *(u32x2*)(gub + (size_t)(nt * 32) * GLD + mt * 32 + 8 * g) = (u32x2){pk2(s0, s1), pk2(s2, s3)};
                            }
                        }
                }
            }
            } else for (;;) {
                if (tid == 0) *su = atomicAdd(&ctr[l + 8 * what], 1u);
                __syncthreads();
                const unsigned u = (unsigned)__builtin_amdgcn_readfirstlane((int)*su);
                __syncthreads();
                if (u >= 1024u) break;
                const unsigned uu = 2u * u + (unsigned)what;
                const int qb = 15 - (int)(uu >> 7), rem = uu & 127, type = rem >> 5, bh = rem & 31, b = bh >> 2, hd = bh & 3;
                const int q0 = qb * 128;
                const bf16_t *Qa, *Ka, *Va, *Qb2, *Kb2, *Vb2; int qs, ksr, nks, mode0, mode1, npass; float scale; const float* cu = nullptr;
                if (type == 0) {
                    Qa = Qb2 = qnsa + (size_t)b * S * 256 + hd * 64; qs = 256; ksr = 64; nks = 4; scale = 0.125f; npass = 2; mode0 = 2; mode1 = 3;
                    Ka = ksb + (size_t)b * S * 64; Kb2 = kwb + (size_t)b * S * 64; Va = vts + (size_t)b * 64 * S; Vb2 = vtw + (size_t)b * 64 * S;
                } else if (type == 1) {
                    Qa = Qb2 = fq + (size_t)b * S * 256 + hd * 64; Ka = Kb2 = fk + (size_t)b * S * 256 + hd * 64; Va = Vb2 = fvt + (size_t)bh * 64 * S;
                    qs = 256; ksr = 256; nks = 4; scale = 0.125f; npass = 1; mode0 = mode1 = 1; cu = cumb + (size_t)bh * S;
                } else if (type == 2) {
                    Qa = Qb2 = mq + (size_t)b * S * 384 + hd * 96; Ka = Kb2 = mk + (size_t)b * S * 384 + hd * 96; Va = Vb2 = mvt + (size_t)bh * 64 * S;
                    qs = 384; ksr = 384; nks = 6; scale = 0.10206207261596577f; npass = 1; mode0 = mode1 = 0;
                } else {
                    Qa = dq + (size_t)b * S * 256 + hd * 64; Qb2 = Qa + 32; Ka = dkb + (size_t)b * S * 256 + hd * 64; Kb2 = Ka + 32; Va = Vb2 = dvt + (size_t)bh * 64 * S;
                    qs = 256; ksr = 256; nks = 2; scale = 0.17677669529663687f; npass = 2; mode0 = mode1 = 0;
                }
                f32x16 O[2];
#pragma nounroll
                for (int pass = 0; pass < npass; ++pass) {
                    attn_pass(pass ? Qb2 : Qa, qs, pass ? Kb2 : Ka, ksr, pass ? Vb2 : Va, cu, selm + (size_t)b * S, scale, nks, pass ? mode1 : mode0, q0, O, smem, wave, lane, tid);
                    if (npass == 2 && pass == 0) {
                        const size_t tok = (size_t)b * S + q0 + wave * 32 + r32;
                        float* tp = ((type == 0) ? ntmp : dtmp) + tok * 256 + hd * 64 + 4 * hh;
                        const float* ocp = ocmp + tok * 256 + hd * 64 + 4 * hh;
                        float g0 = 0.f, g1 = 0.f;
                        if (type == 0) { g0 = gn[tok * 12 + hd]; g1 = gn[tok * 12 + 4 + hd]; }
#pragma unroll
                        for (int dvb = 0; dvb < 2; ++dvb)
#pragma unroll
                            for (int g = 0; g < 4; ++g) {
                                f32x4 v = {O[dvb][4 * g], O[dvb][4 * g + 1], O[dvb][4 * g + 2], O[dvb][4 * g + 3]};
                                f32x4* a = (f32x4*)(tp + dvb * 32 + 8 * g);
                                if (type == 0) { const f32x4 oc = *(const f32x4*)(ocp + dvb * 32 + 8 * g); v = oc * g0 + v * g1; }
                                *a = v;
                            }
                    }
                }
                const int cbase = type * 256;
                const size_t tok = (size_t)b * S + q0 + wave * 32 + r32;
                const float* tp = ((type == 0) ? ntmp : dtmp) + tok * 256 + hd * 64 + 4 * hh;
                if (type == 0) {
                    const float g2 = gn[tok * 12 + 8 + hd];
#pragma unroll
                    for (int dvb = 0; dvb < 2; ++dvb)
#pragma unroll
                        for (int g = 0; g < 4; ++g) {
                            const f32x4 oc = *(const f32x4*)(tp + dvb * 32 + 8 * g);
#pragma unroll
                            for (int e = 0; e < 4; ++e) O[dvb][4 * g + e] = oc[e] + g2 * O[dvb][4 * g + e];
                        }
                } else if (type == 3) {
                    float ss = 0.f;
#pragma unroll
                    for (int dvb = 0; dvb < 2; ++dvb)
#pragma unroll
                        for (int g = 0; g < 4; ++g) {
                            const f32x4 oc = *(const f32x4*)(tp + dvb * 32 + 8 * g);
#pragma unroll
                            for (int e = 0; e < 4; ++e) { const float r = oc[e] - lam * O[dvb][4 * g + e]; O[dvb][4 * g + e] = r; ss += r * r; }
                        }
                    ss += __shfl_xor(ss, 32);
                    const float rstd = rsqrtf(ss * (1.f / 64.f) + EPS);
                    const float* og = p.in[19] + (size_t)l * 64;
#pragma unroll
                    for (int dvb = 0; dvb < 2; ++dvb)
#pragma unroll
                        for (int g = 0; g < 4; ++g) {
                            const f32x4 gg = *(const f32x4*)(og + dvb * 32 + 8 * g + 4 * hh);
#pragma unroll
                            for (int e = 0; e < 4; ++e) O[dvb][4 * g + e] *= rstd * (gg[e] * one_m_lam);
                        }
                }
                store_o(obuf + tok * 1024 + cbase + hd * 64, O, hh);
            }
            }
        } else if (sub == 5 && EN(6)) {
            const int ntn = D / 128;
            for (int k = 0;; ++k) {
                int tm, tn; if (!xcd_unit(k, 16, ntn, tm, tn)) break;
                f32x16 acc[2][2], mg[2][2]; zero_acc(acc); zero_acc(mg);
                const int colb = tn * 128 + wr * 64 + 4 * hh, rowb = tm * 128 + wc * 64 + r32;
                const bf16_t* gub = gates + (size_t)rowb * GLD + colb;
                auto hook = [&](int kt, f32x16 (&a)[2][2]) {
                    if ((kt & 3) == 3) {
                        const bf16_t* gu = gub + (kt >> 2) * 1024;
#pragma unroll
                        for (int mt = 0; mt < 2; ++mt)
#pragma unroll
                            for (int nt = 0; nt < 2; ++nt)
#pragma unroll
                                for (int g = 0; g < 4; ++g) {
                                    const u32x2 gv = *(const u32x2*)(gu + (size_t)(nt * 32) * GLD + mt * 32 + 8 * g);
                                    mg[mt][nt][4 * g + 0] += __uint_as_float(gv[0] << 16) * a[mt][nt][4 * g + 0];
                                    mg[mt][nt][4 * g + 1] += __uint_as_float(gv[0] & 0xffff0000u) * a[mt][nt][4 * g + 1];
                                    mg[mt][nt][4 * g + 2] += __uint_as_float(gv[1] << 16) * a[mt][nt][4 * g + 2];
                                    mg[mt][nt][4 * g + 3] += __uint_as_float(gv[1] & 0xffff0000u) * a[mt][nt][4 * g + 3];
                                    a[mt][nt][4 * g + 0] = 0.f; a[mt][nt][4 * g + 1] = 0.f; a[mt][nt][4 * g + 2] = 0.f; a[mt][nt][4 * g + 3] = 0.f;
                                }
                    }
                };
                gemm_main1<2>(w_br_t, D, RowPlain{tn * 128}, obuf, D, tm * 128, D / 64, acc, smem, hook, tid);
                bf16_t* hub = hbuf + (size_t)rowb * D + colb;
#pragma unroll
                for (int mt = 0; mt < 2; ++mt)
#pragma unroll
                    for (int nt = 0; nt < 2; ++nt)
#pragma unroll
                        for (int g = 0; g < 4; ++g) {
                            u32x2 w = {pk2(mg[mt][nt][4 * g], mg[mt][nt][4 * g + 1]), pk2(mg[mt][nt][4 * g + 2], mg[mt][nt][4 * g + 3])};
                            *(u32x2*)(hub + (size_t)(nt * 32) * D + mt * 32 + 8 * g) = w;
                        }
            }
        } else if ((sub == 6 || sub == 9) && EN(7)) {
            const int ntn = D / 128;
            const bf16_t* A = (sub == 6) ? hbuf : abuf;
            const int lda = (sub == 6) ? D : DFF;
            const bf16_t* Bt = (sub == 6) ? w_o_t : w_dn_t;
            const float* xs = (sub == 6) ? xcur : xo;
            const int og = (sub == 6) ? 2048 : 5120;
            for (int k = 0;; ++k) {
                int tm, tn; if (!xcd_unit(k, 16, ntn, tm, tn)) break;
                f32x16 acc[2][2]; zero_acc(acc);
                gemm_main<2>(A, lda, RowPlain{tm * 128}, Bt, lda, tn * 128, lda / 64, acc, smem, NoHook{}, tid);
                const float* mb = modl + (size_t)(tm * 128 / S) * 6144 + og;
#pragma unroll
                for (int mt = 0; mt < 2; ++mt)
#pragma unroll
                    for (int nt = 0; nt < 2; ++nt)
#pragma unroll
                        for (int i = 0; i < 16; ++i) {
                            const int row = tm * 128 + wr * 64 + mt * 32 + crow(i, hh), col = tn * 128 + wc * 64 + nt * 32 + r32;
                            xo[(size_t)row * D + col] = xs[(size_t)row * D + col] + mb[col] * acc[mt][nt][i];
                        }
            }
        } else if (sub == 8 && EN(8)) {
            const int ntn = 44, ntm = 17;
            const float* cw = p.in[25] + (size_t)l * 3 * DFF;
            const float* cb = p.in[26] + (size_t)l * DFF;
            float* gl = (float*)smem;
            for (int k = 0;; ++k) {
                int tmg, tn; if (!xcd_unit(k, ntm, ntn, tmg, tn)) break;
                const int b = tmg / ntm, tmm = tmg - b * ntm;
                const int t0 = tmm * 126 - 2;
                f32x16 acc[2][2]; zero_acc(acc);
                gemm_main<2>(hbuf, D, RowClamp{b * S, t0}, w_up_t, D, tn * 128, D / 64, acc, smem, NoHook{}, tid);
                {
                    float* wl = gl + (wr * 64 + 4 * hh) * 129 + wc * 64 + r32;
#pragma unroll
                    for (int mt = 0; mt < 2; ++mt)
#pragma unroll
                        for (int nt = 0; nt < 2; ++nt)
#pragma unroll
                            for (int i = 0; i < 16; ++i) wl[(mt * 32 + (i & 3) + 8 * (i >> 2)) * 129 + nt * 32] = acc[mt][nt][i];
                }
                __syncthreads();
                {
                    const int cc = tid & 63, rs = (tid >> 6) * 32, ch = tn * 64 + cc;
                    const float w0 = cw[ch], w1 = cw[DFF + ch], w2 = cw[2 * DFF + ch], bb = cb[ch];
                    float ga = 0.f, gb2 = 0.f;
                    if (rs >= 2) { ga = gl[(rs - 2) * 129 + cc]; gb2 = gl[(rs - 1) * 129 + cc]; }
                    bf16_t* ap = abuf + ((ptrdiff_t)(b * S + t0 + rs)) * DFF + ch;
#pragma unroll 4
                    for (int k = 0; k < 32; ++k) {
                        const int r = rs + k, t = t0 + r;
                        float gc = gl[r * 129 + cc];
                        if (t < 0) gc = 0.f;
                        const float vv = gl[r * 129 + 64 + cc];
                        if (r >= 2 && t < S) ap[(ptrdiff_t)k * DFF] = f2bf(siluf_(w0 * ga + w1 * gb2 + w2 * gc + bb) * vv);
                        ga = gb2; gb2 = gc;
                    }
                }
                __syncthreads();
            }
        }
        if (PROBE_SUB >= 0 || PROBE_MASK != 0u) { if ((sub == PROBE_SUB || ((PROBE_MASK >> sub) & 1u)) && !probe_second) { probe_second = true; --ph; } else probe_second = false; }
    }
}

extern "C" void kernel_launch(void* const* d_in, const int* in_sizes, int n_in, void* d_out, int out_size, void* d_ws, size_t ws_size, hipStream_t stream) {
    static int grid = 0;
    if (grid == 0) {
        if (n_in != 28 || ws_size < WS_END) { fprintf(stderr, "kernel_launch: bad inputs n_in %d ws %zu need %zu\n", n_in, ws_size, (size_t)WS_END); grid = -1; return; }
        int dev = 0, cus = 0, per_cu = 0;
        hipGetDevice(&dev);
        hipDeviceGetAttribute(&cus, hipDeviceAttributeMultiprocessorCount, dev);
        if (hipFuncSetAttribute((const void*)mega, hipFuncAttributeMaxDynamicSharedMemorySize, LDS_BYTES) != hipSuccess) { fprintf(stderr, "hipFuncSetAttribute failed\n"); grid = -1; return; }
        if (hipOccupancyMaxActiveBlocksPerMultiprocessor(&per_cu, (const void*)mega, NT, LDS_BYTES) != hipSuccess || per_cu < 1) { fprintf(stderr, "occupancy query failed\n"); per_cu = 1; }
        if (per_cu > 2) per_cu = 2;
        grid = cus * per_cu;
    }
    if (grid < 0) return;
    if (hipMemsetAsync((char*)d_ws + WS_CTR, 0, 256, stream) != hipSuccess) { fprintf(stderr, "memset failed\n"); return; }
    if (hipMemsetAsync((char*)d_ws + WS_BAR, 0, 16384, stream) != hipSuccess) { fprintf(stderr, "memset failed\n"); return; }
    Params p{};
    for (int i = 0; i < 28; ++i) p.in[i] = (const float*)d_in[i];
    p.out = (float*)d_out; p.ws = (unsigned char*)d_ws; p.ph_lo = 0; p.ph_hi = 1 + NL * 10;
    void* args[] = {&p};
    hipError_t e = hipLaunchCooperativeKernel((const void*)mega, dim3(grid), dim3(NT), args, LDS_BYTES, stream);
    if (e != hipSuccess) fprintf(stderr, "cooperative launch failed: %s (grid %d)\n", hipGetErrorString(e), grid);
}
```
